# Optimizing an MI355X kernel written in HIP

```python
import jax, jax.numpy as jnp
from jax import lax
import numpy as np

D_MODEL = 1024
BATCH = 4
SEQ = 8192
DEPTH = 2

N_HEADS_A = 8
HEAD_DIM = 64
WIDTH_A = N_HEADS_A * HEAD_DIM
N_IDX_HEADS = 8
IDX_DIM = 32
TOPK_MAX = 256
Q_BLOCK = 128
IDX_SCALE = (N_IDX_HEADS ** -0.5) * (IDX_DIM ** -0.5)
N_GROUPS_B = 8
GROUP_DIM_B = 64
WIDTH_B = N_GROUPS_B * GROUP_DIM_B
CHUNK = 128
IN_SPLITS = (WIDTH_A, HEAD_DIM, HEAD_DIM, N_IDX_HEADS * IDX_DIM, IDX_DIM, N_IDX_HEADS, WIDTH_B, WIDTH_B)
IN_WIDTH = WIDTH_A + 2 * HEAD_DIM + N_IDX_HEADS * IDX_DIM + IDX_DIM + N_IDX_HEADS + 2 * WIDTH_B
CONV_WIDTH = 31
D_FF = 4 * D_MODEL
ROPE_THETA = 10000.0
EPS = 1e-6
N_EVEN = (DEPTH + 1) // 2
N_ODD = DEPTH // 2

kernel_name = "hybrid_dsa_gmlp_conformer_block"


def rms_norm(x, g):
    xf = x.astype(jnp.float32)
    y = xf * lax.rsqrt(jnp.mean(xf * xf, axis=-1, keepdims=True) + EPS)
    return (y * g.astype(jnp.float32)).astype(x.dtype)


def rope(x, positions):
    d = x.shape[-1]
    half = d // 2
    inv_freq = ROPE_THETA ** (-jnp.arange(half, dtype=jnp.float32) * 2.0 / d)
    ang = positions.astype(jnp.float32)[..., None] * inv_freq
    cos = jnp.cos(ang)[:, :, None, :]
    sin = jnp.sin(ang)[:, :, None, :]
    xf = x.astype(jnp.float32)
    x1, x2 = xf[..., :half], xf[..., half:]
    out = jnp.concatenate([x1 * cos - x2 * sin, x2 * cos + x1 * sin], axis=-1)
    return out.astype(x.dtype)


def split_columns(z, sizes):
    outs, start = [], 0
    for s in sizes:
        outs.append(z[..., start:start + s])
        start += s
    return outs


def dsa_attention(q, k, v, qi, ki, wi):
    B, S = q.shape[0], q.shape[1]
    topk = min(TOPK_MAX, S // 4)
    nb = S // Q_BLOCK
    key_pos = jnp.arange(S)
    ki32 = ki.astype(jnp.float32)

    def to_blocks(a):
        return a.reshape((B, nb, Q_BLOCK) + a.shape[2:]).swapaxes(0, 1)

    def block_fn(args):
        blk, qb, qib, wib = args
        t = blk * Q_BLOCK + jnp.arange(Q_BLOCK)
        causal = key_pos[None, :] <= t[:, None]
        logits = jnp.einsum('bqhe,bse->bqhs', qib.astype(jnp.float32), ki32)
        score = jnp.einsum('bqh,bqhs->bqs', wib.astype(jnp.float32), jax.nn.relu(logits))
        score = jnp.where(causal[None], score, -jnp.inf)
        _, idx = lax.top_k(score, topk)
        k_sel = jax.vmap(lambda kk, ii: kk[ii])(k, idx)
        v_sel = jax.vmap(lambda vv, ii: vv[ii])(v, idx)
        valid = idx <= t[None, :, None]
        att = jnp.einsum('bqhd,bqkd->bqhk', qb.astype(jnp.float32),
                         k_sel.astype(jnp.float32)) * (HEAD_DIM ** -0.5)
        att = jnp.where(valid[:, :, None, :], att, -jnp.inf)
        p = jax.nn.softmax(att, axis=-1)
        out = jnp.einsum('bqhk,bqkd->bqhd', p, v_sel.astype(jnp.float32))
        return out.astype(qb.dtype)

    out = lax.map(block_fn, (jnp.arange(nb), to_blocks(q), to_blocks(qi), to_blocks(wi)))
    return out.swapaxes(0, 1).reshape(B, S, -1)


def spatial_gating(uv, g_v, w_s, b_s):
    B, S = uv.shape[0], uv.shape[1]
    u, vv = uv[..., :WIDTH_B], uv[..., WIDTH_B:]
    vv = rms_norm(vv, g_v)
    vv = vv.reshape(B, S // CHUNK, CHUNK, N_GROUPS_B, GROUP_DIM_B)
    w = w_s * jnp.tril(jnp.ones((CHUNK, CHUNK), dtype=w_s.dtype))[None]
    sv = jnp.einsum('gij,bcjgd->bcigd', w, vv) + b_s.T[None, None, :, :, None]
    return u * sv.reshape(B, S, WIDTH_B)


def even_layer(x, positions, g_norm, w_in, g_q, g_k, g_kidx, g_vb, w_s, b_s, w_out):
    B, S, _ = x.shape
    h = rms_norm(x, g_norm)
    z = h @ w_in
    q, k, v, qi, ki, wi, u, vb = split_columns(z, IN_SPLITS)
    q = rope(rms_norm(q.reshape(B, S, N_HEADS_A, HEAD_DIM), g_q), positions)
    k = rope(rms_norm(k, g_k)[:, :, None, :], positions)[:, :, 0]
    qi = rope(qi.reshape(B, S, N_IDX_HEADS, IDX_DIM), positions)
    ki = rope(rms_norm(ki, g_kidx)[:, :, None, :], positions)[:, :, 0]
    wi = wi * IDX_SCALE
    a_out = dsa_attention(q, k, v, qi, ki, wi)
    b_out = spatial_gating(jax.nn.gelu(jnp.concatenate([u, vb], axis=-1)), g_vb, w_s, b_s)
    return x + jnp.concatenate([a_out, b_out], axis=-1) @ w_out


def odd_layer(x, g_norm, w_pw1, w_dw, b_dw, g_conv, w_pw2):
    h = rms_norm(x, g_norm)
    z = h @ w_pw1
    y = z[..., :D_MODEL] * jax.nn.sigmoid(z[..., D_MODEL:])
    y = lax.conv_general_dilated(
        y, w_dw[:, None, :].astype(y.dtype), window_strides=(1,),
        padding=[(CONV_WIDTH - 1, 0)], dimension_numbers=('NWC', 'WIO', 'NWC'),
        feature_group_count=D_MODEL) + b_dw
    y = jax.nn.silu(rms_norm(y, g_conv))
    return x + y @ w_pw2


def channel_mixer(x, g_norm, w1, w2):
    h = rms_norm(x, g_norm)
    return x + jnp.square(jax.nn.relu(h @ w1)) @ w2


def setup_inputs(seed: int = 0) -> dict:
    key = jax.random.key(seed)
    ks = jax.random.split(key, 24)
    f32 = jnp.float32
    nrm = lambda k, shape, scale: jax.random.normal(k, shape, f32) * scale
    gain = lambda k, shape: 1.0 + 0.05 * jax.random.normal(k, shape, f32)
    x = jax.random.normal(ks[0], (BATCH, SEQ, D_MODEL), f32)
    offs = jax.random.randint(ks[1], (BATCH, 1), 0, 1024, dtype=jnp.int32)
    positions = (offs + jnp.arange(SEQ, dtype=jnp.int32)[None, :]).astype(jnp.int32)
    return {
        "x": x,
        "positions": positions,
        "ev_g_norm": gain(ks[2], (N_EVEN, D_MODEL)),
        "ev_w_in": nrm(ks[3], (N_EVEN, D_MODEL, IN_WIDTH), D_MODEL ** -0.5),
        "ev_g_q": gain(ks[4], (N_EVEN, HEAD_DIM)),
        "ev_g_k": gain(ks[5], (N_EVEN, HEAD_DIM)),
        "ev_g_kidx": gain(ks[6], (N_EVEN, IDX_DIM)),
        "ev_g_vb": gain(ks[7], (N_EVEN, WIDTH_B)),
        "ev_w_s": nrm(ks[8], (N_EVEN, N_GROUPS_B, CHUNK, CHUNK), 0.5 * CHUNK ** -0.5),
        "ev_b_s": 1.0 + nrm(ks[9], (N_EVEN, N_GROUPS_B, CHUNK), 0.05),
        "ev_w_out": nrm(ks[10], (N_EVEN, WIDTH_A + WIDTH_B, D_MODEL), (WIDTH_A + WIDTH_B) ** -0.5),
        "od_g_norm": gain(ks[11], (N_ODD, D_MODEL)),
        "od_w_pw1": nrm(ks[12], (N_ODD, D_MODEL, 2 * D_MODEL), D_MODEL ** -0.5),
        "od_w_dw": nrm(ks[13], (N_ODD, CONV_WIDTH, D_MODEL), CONV_WIDTH ** -0.5),
        "od_b_dw": nrm(ks[14], (N_ODD, D_MODEL), 0.01),
        "od_g_conv": gain(ks[15], (N_ODD, D_MODEL)),
        "od_w_pw2": nrm(ks[16], (N_ODD, D_MODEL, D_MODEL), D_MODEL ** -0.5),
        "ff_g_norm": gain(ks[17], (DEPTH, D_MODEL)),
        "ff_w1": nrm(ks[18], (DEPTH, D_MODEL, D_FF), D_MODEL ** -0.5),
        "ff_w2": nrm(ks[19], (DEPTH, D_FF, D_MODEL), 0.5 * D_FF ** -0.5),
    }


def reference(x, positions, ev_g_norm, ev_w_in, ev_g_q, ev_g_k, ev_g_kidx, ev_g_vb,
              ev_w_s, ev_b_s, ev_w_out, od_g_norm, od_w_pw1, od_w_dw, od_b_dw,
              od_g_conv, od_w_pw2, ff_g_norm, ff_w1, ff_w2):
    for layer in range(DEPTH):
        i = layer // 2
        if layer % 2 == 0:
            x = even_layer(x, positions, ev_g_norm[i], ev_w_in[i], ev_g_q[i], ev_g_k[i],
                           ev_g_kidx[i], ev_g_vb[i], ev_w_s[i], ev_b_s[i], ev_w_out[i])
        else:
            x = odd_layer(x, od_g_norm[i], od_w_pw1[i], od_w_dw[i], od_b_dw[i],
                          od_g_conv[i], od_w_pw2[i])
        x = channel_mixer(x, ff_g_norm[layer], ff_w1[layer], ff_w2[layer])
    return x
```

```cpp
#include <hip/hip_runtime.h>
#include <cstdio>
#include <cstdint>
#include <cmath>
namespace pg8 {
#define PG8_LAS __attribute__((address_space(3)))
typedef unsigned short bf16_t;
typedef short bf16x8 __attribute__((ext_vector_type(8)));
typedef float f32x4 __attribute__((ext_vector_type(4)));
typedef unsigned u32x4 __attribute__((ext_vector_type(4)));
constexpr int BM = 256, BK = 64, HALF = 128, HTB = HALF * BK * 2  , STAGE_BYTES = 8 * HTB, NXCD = 8, WGM = 8;

__host__ __device__ __forceinline__ int lds_byte(int r, int c) { const int st = (r >> 4) * 2 + (c >> 5), rr = r & 15, cc = c & 31, ob = rr * 64 + cc * 2; return st * 1024 + (ob ^ (((ob >> 9) & 1) << 5)); }
__host__ __device__ __forceinline__ void stage_rc(int b, int& R, int& C) { const int st = b / 1024, sb = b % 1024, swz = sb ^ (((sb >> 9) & 1) << 5); R = (st >> 1) * 16 + swz / 64; C = (st & 1) * 32 + (swz % 64) / 2; }
__host__ __device__ __forceinline__ int perm32(int rho) { const int n = rho >> 4, i = rho & 15; return 8 * (i >> 2) + 4 * n + (i & 3); }

struct Unit { int pm, pn; };
struct Gemm { const bf16_t* A; const bf16_t* Bt; int M, N, K; };

struct StaticOrder {
    int nM, nN, nwg, G, c;
    __host__ __device__ void init(int M, int N, int G_, int c_) { nM = M / BM; nN = N / BM; nwg = nM * nN; G = G_; c = c_; }
    __host__ __device__ bool next(int i, Unit& u) const {
        const long L = (long)i * G + c; if (L >= nwg) return false;
        int wgid = (int)L; { const int q = nwg / NXCD, r = nwg % NXCD, xcd = wgid % NXCD, off = wgid / NXCD; wgid = (xcd < r ? xcd * (q + 1) : r * (q + 1) + (xcd - r) * q) + off; }
        const int nig = WGM * nN, gid = wgid / nig, fm = gid * WGM, gsz = (nM - fm) < WGM ? (nM - fm) : WGM;
        u.pm = fm + ((wgid % nig) % gsz); u.pn = (wgid % nig) / gsz; return true;
    }
    __device__ __forceinline__ void a_ready(const Unit&) const {}
    __device__ __forceinline__ void done(const Unit&) const {}
};

__device__ __forceinline__ unsigned cvt_pk_bf16(float lo, float hi) { unsigned r; asm volatile("v_cvt_pk_bf16_f32 %0, %1, %2" : "=v"(r) : "v"(lo), "v"(hi)); return r; }
typedef unsigned u32x2 __attribute__((ext_vector_type(2)));
constexpr float RMS_EPS = 1e-6f;
__device__ __forceinline__ float dot4(const f32x4 a) { return (a[0] * a[0] + a[1] * a[1]) + (a[2] * a[2] + a[3] * a[3]); }
__device__ __forceinline__ float row_rinv(const float* ssq, int row) {
    const f32x4* p = (const f32x4*)(ssq + (size_t)row * 16);
    const f32x4 a = p[0], b = p[1], c = p[2], d = p[3];
    const float s = ((a[0] + a[1]) + (a[2] + a[3])) + ((b[0] + b[1]) + (b[2] + b[3])) + ((c[0] + c[1]) + (c[2] + c[3])) + ((d[0] + d[1]) + (d[2] + d[3]));
    return __builtin_amdgcn_rsqf(s * (1.0f / 1024.0f) + RMS_EPS);
}
__device__ __forceinline__ float gelu_tanh1(float x) {
    const float t = x * (0.7978845608028654f + 0.035677408136300125f * x * x);
    const float e = __builtin_amdgcn_exp2f(t * -2.8853900817779268f);
    return x * __builtin_amdgcn_rcpf(1.0f + e);
}
__device__ __forceinline__ f32x4 gelu4(const f32x4 v) { return (f32x4){gelu_tanh1(v[0]), gelu_tanh1(v[1]), gelu_tanh1(v[2]), gelu_tanh1(v[3])}; }
__device__ __forceinline__ void st_bf16x4(bf16_t* p, const f32x4 v) { u32x2 w; w.x = cvt_pk_bf16(v[0], v[1]); w.y = cvt_pk_bf16(v[2], v[3]); *(u32x2*)p = w; }

struct EpiIn {
    static constexpr bool PERM = false, AFTER_DRAIN = false;
    const float* ssq; const float* cos64; const float* sin64; const float* cos32; const float* sin32;
    const float* gq; const float* gk; const float* gki;
    bf16_t* Q; bf16_t* Kb; bf16_t* Vb; float* Qi; float* Ki; float* Wi; bf16_t* U; bf16_t* VBg; float* ssqv;
    __device__ __forceinline__ void operator()(const f32x4 (&acc)[2][2][4][2], const Unit& u, int wr, int wc, int fr, int fq) const {
        const int pn = u.pn;
        const int rowb = u.pm * BM + wr * 64 + fr;
        if (pn < 2 || (pn == 2 && wc == 0)) {
            const float* g = pn < 2 ? gq : gk;
            const f32x4 g00 = *(const f32x4*)(g + 4 * fq), g01 = *(const f32x4*)(g + 16 + 4 * fq), g10 = *(const f32x4*)(g + 32 + 4 * fq), g11 = *(const f32x4*)(g + 48 + 4 * fq);
            const float osc = pn < 2 ? 0.125f : 1.0f;
#pragma unroll
            for (int ai = 0; ai < 2; ++ai)
#pragma unroll
                for (int m = 0; m < 4; ++m) {
                    const int row = rowb + ai * HALF + m * 16; const float ri = row_rinv(ssq, row);
                    const f32x4 v00 = acc[ai][0][m][0] * ri, v01 = acc[ai][0][m][1] * ri, v10 = acc[ai][1][m][0] * ri, v11 = acc[ai][1][m][1] * ri;
                    float ss = (dot4(v00) + dot4(v01)) + (dot4(v10) + dot4(v11));
                    ss += __shfl_xor(ss, 16); ss += __shfl_xor(ss, 32);
                    const float rn = __builtin_amdgcn_rsqf(ss * (1.0f / 64.0f) + RMS_EPS) * osc;
                    const f32x4 y00 = v00 * rn * g00, y01 = v01 * rn * g01, y10 = v10 * rn * g10, y11 = v11 * rn * g11;
                    const f32x4 c0 = *(const f32x4*)(cos64 + (size_t)row * 32 + 4 * fq), c1 = *(const f32x4*)(cos64 + (size_t)row * 32 + 16 + 4 * fq);
                    const f32x4 s0 = *(const f32x4*)(sin64 + (size_t)row * 32 + 4 * fq), s1 = *(const f32x4*)(sin64 + (size_t)row * 32 + 16 + 4 * fq);
                    const f32x4 o00 = y00 * c0 - y10 * s0, o10 = y10 * c0 + y00 * s0, o01 = y01 * c1 - y11 * s1, o11 = y11 * c1 + y01 * s1;
                    bf16_t* dst = pn < 2 ? Q + (size_t)row * 512 + (4 * pn + wc) * 64 + 4 * fq : Kb + (size_t)row * 64 + 4 * fq;
                    st_bf16x4(dst, o00); st_bf16x4(dst + 16, o01); st_bf16x4(dst + 32, o10); st_bf16x4(dst + 48, o11);
                }
        } else if (pn == 2) {
            if (wc == 1) {
#pragma unroll
                for (int ai = 0; ai < 2; ++ai)
#pragma unroll
                    for (int m = 0; m < 4; ++m) {
                        const int row = rowb + ai * HALF + m * 16; const float ri = row_rinv(ssq, row);
                        bf16_t* dst = Vb + (size_t)row * 64 + 4 * fq;
                        st_bf16x4(dst, acc[ai][0][m][0] * ri); st_bf16x4(dst + 16, acc[ai][0][m][1] * ri); st_bf16x4(dst + 32, acc[ai][1][m][0] * ri); st_bf16x4(dst + 48, acc[ai][1][m][1] * ri);
                    }
            } else if (wc == 2) {
                const f32x4 g0 = *(const f32x4*)(gki + 4 * fq), g1 = *(const f32x4*)(gki + 16 + 4 * fq);
#pragma unroll
                for (int ai = 0; ai < 2; ++ai)
#pragma unroll
                    for (int m = 0; m < 4; ++m) {
                        const int row = rowb + ai * HALF + m * 16; const float ri = row_rinv(ssq, row);
                        const f32x4 v0 = acc[ai][0][m][0] * ri, v1 = acc[ai][1][m][0] * ri;
                        float ss = dot4(v0) + dot4(v1);
                        ss += __shfl_xor(ss, 16); ss += __shfl_xor(ss, 32);
                        const float rn = __builtin_amdgcn_rsqf(ss * (1.0f / 32.0f) + RMS_EPS);
                        const f32x4 y0 = v0 * rn * g0, y1 = v1 * rn * g1;
                        const f32x4 c = *(const f32x4*)(cos32 + (size_t)row * 16 + 4 * fq), s = *(const f32x4*)(sin32 + (size_t)row * 16 + 4 * fq);
                        *(f32x4*)(Ki + (size_t)row * 32 + 4 * fq) = y0 * c - y1 * s;
                        *(f32x4*)(Ki + (size_t)row * 32 + 16 + 4 * fq) = y1 * c + y0 * s;
                        if (fq < 2) *(f32x4*)(Wi + (size_t)row * 8 + 4 * fq) = acc[ai][0][m][1] * (ri * 0.0625f);
                    }
            }
        } else if (pn == 3) {
#pragma unroll
            for (int ai = 0; ai < 2; ++ai)
#pragma unroll
                for (int m = 0; m < 4; ++m) {
                    const int row = rowb + ai * HALF + m * 16; const float ri = row_rinv(ssq, row);
                    const f32x4 c = *(const f32x4*)(cos32 + (size_t)row * 16 + 4 * fq), s = *(const f32x4*)(sin32 + (size_t)row * 16 + 4 * fq);
#pragma unroll
                    for (int n = 0; n < 2; ++n) {
                        const f32x4 x1 = acc[ai][0][m][n] * ri, x2 = acc[ai][1][m][n] * ri;
                        float* dst = Qi + (size_t)row * 256 + (2 * wc + n) * 32 + 4 * fq;
                        *(f32x4*)dst = x1 * c - x2 * s; *(f32x4*)(dst + 16) = x2 * c + x1 * s;
                    }
                }
        } else {
            const bool isv = pn >= 6;
            bf16_t* O = isv ? VBg : U; const int colt = (pn & 1) * 256 + wc * 32 + 4 * fq;
#pragma unroll
            for (int ai = 0; ai < 2; ++ai)
#pragma unroll
                for (int m = 0; m < 4; ++m) {
                    const int row = rowb + ai * HALF + m * 16; const float ri = row_rinv(ssq, row);
                    float ss = 0.f;
#pragma unroll
                    for (int bj = 0; bj < 2; ++bj)
#pragma unroll
                        for (int n = 0; n < 2; ++n) { const f32x4 gv = gelu4(acc[ai][bj][m][n] * ri); ss += dot4(gv); st_bf16x4(O + (size_t)row * 512 + colt + bj * HALF + n * 16, gv); }
                    if (isv) { ss += __shfl_xor(ss, 16); ss += __shfl_xor(ss, 32); if (fq == 0) ssqv[(size_t)row * 8 + (pn - 6) * 4 + wc] = ss; }
                }
        }
    }
};
struct EpiRes {
    static constexpr bool PERM = false, AFTER_DRAIN = false;
    const float* base; float* out; bf16_t* xb; float* ssq;
    __device__ __forceinline__ void operator()(const f32x4 (&acc)[2][2][4][2], const Unit& u, int wr, int wc, int fr, int fq) const {
        const int rowb = u.pm * BM + wr * 64 + fr, col0 = u.pn * BM + wc * 32 + 4 * fq;
#pragma unroll
        for (int ai = 0; ai < 2; ++ai)
#pragma unroll
            for (int m = 0; m < 4; ++m) {
                const int row = rowb + ai * HALF + m * 16; const size_t off = (size_t)row * 1024 + col0; float ss = 0.f;
#pragma unroll
                for (int bj = 0; bj < 2; ++bj)
#pragma unroll
                    for (int n = 0; n < 2; ++n) { const size_t o2 = off + bj * HALF + n * 16; const f32x4 o = *(const f32x4*)(base + o2) + acc[ai][bj][m][n]; *(f32x4*)(out + o2) = o; ss += dot4(o); if (xb) st_bf16x4(xb + o2, o); }
                if (ssq) { ss += __shfl_xor(ss, 16); ss += __shfl_xor(ss, 32); if (fq == 0) ssq[(size_t)row * 16 + u.pn * 4 + wc] = ss; }
            }
    }
};
struct EpiUp {
    static constexpr bool PERM = true, AFTER_DRAIN = false;
    const float* ssq; bf16_t* O; int ldc;
    __device__ __forceinline__ void operator()(const f32x4 (&acc)[2][2][4][2], const Unit& u, int wr, int wc, int fr, int fq) const {
        const int rowb = u.pm * BM + wr * 64 + fr, col0 = u.pn * BM + wc * 32 + 8 * fq;
#pragma unroll
        for (int ai = 0; ai < 2; ++ai)
#pragma unroll
            for (int m = 0; m < 4; ++m) {
                const int row = rowb + ai * HALF + m * 16; const float ri = row_rinv(ssq, row); bf16_t* rowp = O + (size_t)row * ldc + col0;
#pragma unroll
                for (int bj = 0; bj < 2; ++bj) {
                    f32x4 v0 = acc[ai][bj][m][0] * ri, v1 = acc[ai][bj][m][1] * ri;
#pragma unroll
                    for (int i = 0; i < 4; ++i) { const float a = fmaxf(v0[i], 0.f), b = fmaxf(v1[i], 0.f); v0[i] = a * a; v1[i] = b * b; }
                    u32x4 w; w.x = cvt_pk_bf16(v0[0], v0[1]); w.y = cvt_pk_bf16(v0[2], v0[3]); w.z = cvt_pk_bf16(v1[0], v1[1]); w.w = cvt_pk_bf16(v1[2], v1[3]);
                    *(u32x4*)(rowp + bj * HALF) = w;
                }
            }
    }
};
struct EpiGlu {
    static constexpr bool PERM = false, AFTER_DRAIN = false;
    const float* ssq; bf16_t* Y;
    __device__ __forceinline__ void operator()(const f32x4 (&acc)[2][2][4][2], const Unit& u, int wr, int wc, int fr, int fq) const {
        const int rowb = u.pm * BM + wr * 64 + fr, col0 = u.pn * HALF + wc * 32 + 4 * fq;
#pragma unroll
        for (int ai = 0; ai < 2; ++ai)
#pragma unroll
            for (int m = 0; m < 4; ++m) {
                const int row = rowb + ai * HALF + m * 16; const float ri = row_rinv(ssq, row);
#pragma unroll
                for (int n = 0; n < 2; ++n) {
                    const f32x4 a = acc[ai][0][m][n] * ri, b = acc[ai][1][m][n] * ri; f32x4 y;
#pragma unroll
                    for (int i = 0; i < 4; ++i) y[i] = a[i] * __builtin_amdgcn_rcpf(1.0f + __builtin_amdgcn_exp2f(b[i] * -1.4426950408889634f));
                    st_bf16x4(Y + (size_t)row * 1024 + col0 + n * 16, y);
                }
            }
    }
};
template <class Epi, class Sched, bool ALIGN_EPI = false, bool SP2 = false>
__device__ __forceinline__ void gemm_phase(PG8_LAS unsigned char* lds, const Gemm g, const Sched& S, const Epi& E) {
    const int tid = threadIdx.x, wid = __builtin_amdgcn_readfirstlane(tid >> 6), lane = tid & 63, wr = wid >> 2, wc = wid & 3, fr = lane & 15, fq = lane >> 4;
    const int K = g.K, nt = K / BK;
    unsigned voffA[2], voffB[2];
#pragma unroll
    for (int i = 0; i < 2; ++i) { int R, C; stage_rc(tid * 16 + i * 8192, R, C); const int Rb = Epi::PERM ? ((R & ~31) + perm32(R & 31)) : R;
        voffA[i] = (unsigned)(R * K + C) * 2u; voffB[i] = (unsigned)(Rb * K + C) * 2u; }
    const size_t kstep = (size_t)(BK * 2);
    const size_t hstep = (size_t)HALF * K * 2;
    const size_t tstep = 2 * hstep;
    const unsigned ldsw = (unsigned)wid * 1024u;
    const int aoff = lds_byte(wr * 64 + fr, fq * 8), boff = lds_byte(wc * 32 + fr, fq * 8);
#define PG8_SA(b, h) (((b) * 2 + (h)) * HTB)
#define PG8_SB(b, h) ((4 + (b) * 2 + (h)) * HTB)
#define PG8_STAGE(bufoff, gbase, voff) do { _Pragma("unroll") for (int _i = 0; _i < 2; ++_i) \
        __builtin_amdgcn_global_load_lds((const unsigned*)((const char*)(gbase) + (voff)[_i]), (PG8_LAS unsigned*)(lds + (bufoff) + ldsw + _i * 8192), 16, 0, 0); } while (0)
#define PG8_LDA(dst, b, h) do { _Pragma("unroll") for (int m = 0; m < 4; ++m) _Pragma("unroll") for (int k = 0; k < 2; ++k) dst[m][k] = *(const PG8_LAS bf16x8*)(lds + PG8_SA(b, h) + aoff + m * 2048 + k * 1024); } while (0)
#define PG8_LDB(dst, b, h) do { _Pragma("unroll") for (int n = 0; n < 2; ++n) _Pragma("unroll") for (int k = 0; k < 2; ++k) dst[n][k] = *(const PG8_LAS bf16x8*)(lds + PG8_SB(b, h) + boff + n * 2048 + k * 1024); } while (0)
#define PG8_MMA(ai, bj, At, Bt) do { __builtin_amdgcn_s_setprio(1); _Pragma("unroll") for (int m = 0; m < 4; ++m) _Pragma("unroll") for (int n = 0; n < 2; ++n) _Pragma("unroll") for (int k = 0; k < 2; ++k) \
        acc[ai][bj][m][n] = __builtin_amdgcn_mfma_f32_16x16x32_bf16(Bt[n][k], At[m][k], acc[ai][bj][m][n], 0, 0, 0); __builtin_amdgcn_s_setprio(0); } while (0)
#define PG8_WAIT_V(n) asm volatile("s_waitcnt vmcnt(" #n ")" ::: "memory")
#define PG8_WAIT_L(n) asm volatile("s_waitcnt lgkmcnt(" #n ")" ::: "memory")
#define PG8_BAR __builtin_amdgcn_s_barrier()
#define PG8_SCHED __builtin_amdgcn_sched_barrier(0)
    Unit cur, nxt; int ui = 0;
    if (!S.next(0, cur)) return;
    f32x4 acc[2][2][4][2];
#pragma unroll
    for (int a = 0; a < 2; ++a)
#pragma unroll
        for (int b = 0; b < 2; ++b)
#pragma unroll
            for (int m = 0; m < 4; ++m)
#pragma unroll
                for (int n = 0; n < 2; ++n) acc[a][b][m][n] = (f32x4){0.f, 0.f, 0.f, 0.f};
    bf16x8 At[4][2], B0[2][2], B1[2][2];
    const char* cA = (const char*)g.A + (size_t)cur.pm * tstep; const char* cB = (const char*)g.Bt + (size_t)cur.pn * tstep;
    S.a_ready(cur);
    if constexpr (SP2) {
        PG8_STAGE(PG8_SB(0, 0), cB, voffB); PG8_STAGE(PG8_SB(0, 1), cB + hstep, voffB); PG8_STAGE(PG8_SA(0, 0), cA, voffA); PG8_STAGE(PG8_SA(0, 1), cA + hstep, voffA);
        if (wr == 1) PG8_BAR;
        PG8_WAIT_V(2); PG8_BAR;
        PG8_STAGE(PG8_SB(1, 0), cB + kstep, voffB); PG8_STAGE(PG8_SA(1, 0), cA + kstep, voffA); PG8_STAGE(PG8_SB(1, 1), cB + hstep + kstep, voffB);
        PG8_WAIT_V(6); PG8_BAR;
    } else {
        PG8_STAGE(PG8_SB(0, 0), cB, voffB); PG8_STAGE(PG8_SA(0, 0), cA, voffA); PG8_STAGE(PG8_SB(0, 1), cB + hstep, voffB); PG8_STAGE(PG8_SA(0, 1), cA + hstep, voffA);
        if (wr == 1) PG8_BAR;
        PG8_WAIT_V(4); PG8_BAR;
        PG8_STAGE(PG8_SB(1, 0), cB + kstep, voffB); PG8_STAGE(PG8_SA(1, 0), cA + kstep, voffA); PG8_STAGE(PG8_SB(1, 1), cB + hstep + kstep, voffB);
        PG8_WAIT_V(6); PG8_BAR;
    }
    for (;;) {
        const bool has_next = S.next(ui + 1, nxt);
        const char* nA = has_next ? (const char*)g.A + (size_t)nxt.pm * tstep : cA; const char* nB = has_next ? (const char*)g.Bt + (size_t)nxt.pn * tstep : cB;
        for (int t = 0; t < nt; t += 2) {
            const bool last = (t == nt - 2);
            const char* a1 = cA + (size_t)(t + 1) * kstep;
            const char* a2 = last ? nA : cA + (size_t)(t + 2) * kstep; const char* b2 = last ? nB : cB + (size_t)(t + 2) * kstep;
            const char* a3 = a2 + kstep; const char* b3 = b2 + kstep;
            if (last && has_next) S.a_ready(nxt);
            if constexpr (SP2) {
            PG8_LDB(B0, 0, 0); PG8_LDB(B1, 0, 1); PG8_SCHED; PG8_LDA(At, 0, 0); PG8_STAGE(PG8_SA(1, 1), a1 + hstep, voffA);
            PG8_WAIT_V(8); PG8_WAIT_L(0); PG8_BAR; PG8_MMA(0, 0, At, B0); PG8_MMA(0, 1, At, B1); PG8_BAR; PG8_SCHED;
            PG8_LDA(At, 0, 1); PG8_STAGE(PG8_SB(0, 0), b2, voffB); PG8_STAGE(PG8_SB(0, 1), b2 + hstep, voffB); PG8_STAGE(PG8_SA(0, 0), a2, voffA);
            PG8_WAIT_V(8); PG8_WAIT_L(0); PG8_BAR; PG8_MMA(1, 0, At, B0); PG8_MMA(1, 1, At, B1); PG8_BAR; PG8_SCHED;
            PG8_LDB(B0, 1, 0); PG8_LDB(B1, 1, 1); PG8_SCHED; PG8_LDA(At, 1, 0); PG8_STAGE(PG8_SA(0, 1), a2 + hstep, voffA);
            PG8_WAIT_V(8); PG8_WAIT_L(0); PG8_BAR; PG8_MMA(0, 0, At, B0); PG8_MMA(0, 1, At, B1); PG8_BAR; PG8_SCHED;
            PG8_LDA(At, 1, 1); PG8_STAGE(PG8_SB(1, 0), b3, voffB); PG8_STAGE(PG8_SB(1, 1), b3 + hstep, voffB); PG8_STAGE(PG8_SA(1, 0), a3, voffA);
            PG8_WAIT_V(8); PG8_WAIT_L(0); PG8_BAR; PG8_MMA(1, 0, At, B0); PG8_MMA(1, 1, At, B1); PG8_BAR; PG8_SCHED;
            } else {
            PG8_LDB(B0, 0, 0); PG8_SCHED; PG8_LDA(At, 0, 0); PG8_STAGE(PG8_SA(1, 1), a1 + hstep, voffA);
            PG8_WAIT_L(8); PG8_BAR; PG8_WAIT_L(0); PG8_MMA(0, 0, At, B0); PG8_BAR; PG8_SCHED;
            PG8_LDB(B1, 0, 1); PG8_STAGE(PG8_SB(0, 0), b2, voffB);
            PG8_BAR; PG8_WAIT_L(0); PG8_MMA(0, 1, At, B1); PG8_BAR;
            PG8_LDA(At, 0, 1); PG8_STAGE(PG8_SA(0, 0), a2, voffA);
            PG8_BAR; PG8_WAIT_L(0); PG8_MMA(1, 0, At, B0); PG8_BAR; PG8_SCHED;
            PG8_STAGE(PG8_SB(0, 1), b2 + hstep, voffB);
            PG8_WAIT_V(6); PG8_BAR; PG8_MMA(1, 1, At, B1); PG8_BAR;
            PG8_LDB(B0, 1, 0); PG8_SCHED; PG8_LDA(At, 1, 0); PG8_STAGE(PG8_SA(0, 1), a2 + hstep, voffA);
            PG8_WAIT_L(8); PG8_BAR; PG8_WAIT_L(0); PG8_MMA(0, 0, At, B0); PG8_BAR; PG8_SCHED;
            PG8_LDB(B1, 1, 1); PG8_STAGE(PG8_SB(1, 0), b3, voffB);
            PG8_BAR; PG8_WAIT_L(0); PG8_MMA(0, 1, At, B1); PG8_BAR;
            PG8_LDA(At, 1, 1); PG8_STAGE(PG8_SA(1, 0), a3, voffA);
            PG8_BAR; PG8_WAIT_L(0); PG8_MMA(1, 0, At, B0); PG8_BAR; PG8_SCHED;
            PG8_STAGE(PG8_SB(1, 1), b3 + hstep, voffB);
            PG8_WAIT_V(6); PG8_BAR; PG8_MMA(1, 1, At, B1); PG8_BAR;
            }
        }
        if constexpr (ALIGN_EPI) { if (wr == 0) PG8_BAR; }
        if constexpr (!Epi::AFTER_DRAIN) { E(acc, cur, wr, wc, fr, fq); S.done(cur); }
        if (!has_next) break;
#pragma unroll
        for (int a = 0; a < 2; ++a)
#pragma unroll
            for (int b = 0; b < 2; ++b)
#pragma unroll
                for (int m = 0; m < 4; ++m)
#pragma unroll
                    for (int n = 0; n < 2; ++n) acc[a][b][m][n] = (f32x4){0.f, 0.f, 0.f, 0.f};
        cur = nxt; cA = nA; cB = nB; ++ui;
        if constexpr (ALIGN_EPI) { if (wr == 1) PG8_BAR; }
    }
    PG8_WAIT_V(0);
    if constexpr (!ALIGN_EPI) { if (wr == 0) PG8_BAR; }
    PG8_BAR;
    if constexpr (Epi::AFTER_DRAIN) { E.fused(acc, cur, wr, wc, fr, fq, lds, wid, lane); S.done(cur); }
#undef PG8_SA
#undef PG8_SB
#undef PG8_STAGE
#undef PG8_LDA
#undef PG8_LDB
#undef PG8_MMA
#undef PG8_WAIT_V
#undef PG8_WAIT_L
#undef PG8_BAR
#undef PG8_SCHED
}
}

constexpr int NWAVES = 8;
constexpr int BATCH = 4, SEQ = 8192, D = 1024, M = BATCH * SEQ;
constexpr int NH = 8, HD = 64, WA = 512, NIH = 8, IDD = 32, TOPK = 256, WB = 512, NG = 8, GD = 64, CHUNK = 128;
constexpr int INW = 1960, INWP = 2048, FF = 4096, CW = 31;
constexpr float EPS = 1e-6f;
#ifndef MK_ONE_LAUNCH
#define MK_ONE_LAUNCH 0
#endif
constexpr int N_PHASES = 11;

constexpr size_t MiB = 1u << 20;
constexpr size_t WS_CTL = 0, CTL_ZERO_BYTES = 1 * MiB;
constexpr size_t WS_WIN = 1 * MiB;
constexpr size_t WS_WOUT = 5 * MiB;
constexpr size_t WS_W1 = 7 * MiB;
constexpr size_t WS_W2 = 23 * MiB;
constexpr size_t WS_WPW1 = 39 * MiB;
constexpr size_t WS_WPW2 = 43 * MiB;
constexpr size_t WS_SSQ = 45 * MiB;
constexpr size_t WS_COS64 = 47 * MiB, WS_SIN64 = 51 * MiB;
constexpr size_t WS_COS32 = 55 * MiB, WS_SIN32 = 57 * MiB;
constexpr size_t WS_XB = 59 * MiB;
constexpr size_t WS_BIG = 123 * MiB;
constexpr size_t WS_Q = WS_BIG;
constexpr size_t WS_QI = WS_BIG + 32 * MiB;
constexpr size_t WS_U = WS_BIG + 64 * MiB;
constexpr size_t WS_VBG = WS_BIG + 96 * MiB;
constexpr size_t WS_MIX = WS_BIG + 128 * MiB;
constexpr size_t WS_KB = WS_BIG + 192 * MiB;
constexpr size_t WS_VB = WS_BIG + 196 * MiB;
constexpr size_t WS_KI = WS_BIG + 200 * MiB;
constexpr size_t WS_WI = WS_BIG + 204 * MiB;
constexpr size_t WS_SSQV = WS_BIG + 205 * MiB;
constexpr size_t WS_Y = WS_BIG;
constexpr size_t WS_YC = WS_BIG + 64 * MiB;
constexpr size_t WS_HID1 = WS_BIG;
constexpr size_t WS_END = WS_BIG + 256 * MiB;
constexpr int CW_BAR = 4096;

constexpr int RING_OFF = 0, RING_BYTES = 131072;
constexpr int LDSCTL_OFF = RING_BYTES, MISC_OFF = LDSCTL_OFF + 320;
constexpr int LDS_BYTES = 147456;

#define GAS __attribute__((address_space(1)))
#define LAS __attribute__((address_space(3)))
typedef unsigned short bf16;
typedef unsigned v4u __attribute__((ext_vector_type(4)));
typedef unsigned v2u __attribute__((ext_vector_type(2)));
typedef float f32x4 __attribute__((ext_vector_type(4)));
typedef GAS unsigned gu32;
#define RLX_AGENT __ATOMIC_RELAXED, __HIP_MEMORY_SCOPE_AGENT
#define LDS_WAIT() asm volatile("s_waitcnt lgkmcnt(0)" ::: "memory")
#define VM_WAIT() asm volatile("s_waitcnt vmcnt(0)" ::: "memory")
__device__ __forceinline__ unsigned f2bf(float f) { unsigned u = __builtin_bit_cast(unsigned, f); return (u + 0x7fffu + ((u >> 16) & 1u)) >> 16; }
__device__ __forceinline__ unsigned pk2(float lo, float hi) { return f2bf(lo) | (f2bf(hi) << 16); }
__device__ __forceinline__ float bf2f(unsigned short h) { return __builtin_bit_cast(float, (unsigned)h << 16); }
__device__ __forceinline__ float bflo(unsigned w) { return __builtin_bit_cast(float, w << 16); }
__device__ __forceinline__ float bfhi(unsigned w) { return __builtin_bit_cast(float, w & 0xffff0000u); }
#define XB_TMO      128
#define XB_XCNT(j)  (256  + 64 * (j))
#define XB_XSUB(j)  (1280 + 64 * (j))
#define XB_XGEN(j)  (2304 + 64 * (j))
#define XB_TOP      3328
#define XB_TOPGEN   3392
#define XCD_BAR_WORDS 3456
#define XB_SPIN_CAP (1u << 18)

__device__ __forceinline__ unsigned xb_ld(unsigned* p)              { return __hip_atomic_load(p, __ATOMIC_RELAXED, __HIP_MEMORY_SCOPE_AGENT); }
__device__ __forceinline__ unsigned xb_add(unsigned* p, unsigned v) { return __hip_atomic_fetch_add(p, v, __ATOMIC_RELAXED, __HIP_MEMORY_SCOPE_AGENT); }
__device__ __forceinline__ unsigned xb_xcc_id() { return (unsigned)__builtin_amdgcn_s_getreg((3 << 11) | 20) & 0xFu; }
#define XB_SPIN(cond, bar) do { unsigned _sp = 0; while (cond) { __builtin_amdgcn_s_sleep(1); \
    if ((++_sp & 255u) == 0u) { if (xb_ld(&(bar)[XB_TMO])) break; if (_sp > XB_SPIN_CAP) { atomicAdd(&(bar)[XB_TMO], 1u); break; } } } } while (0)

struct XcdBarrier {
    unsigned* bar; unsigned x;
    volatile LAS unsigned* st;
};

__device__ __forceinline__ XcdBarrier xcd_barrier_post(unsigned* bar, volatile LAS unsigned* st) {
    XcdBarrier b; b.bar = bar; b.x = xb_xcc_id(); b.st = st;
    if (threadIdx.x == 0) (void)xb_add(&bar[XB_XCNT(b.x)], 1u);
    return b;
}
__device__ __forceinline__ void xcd_barrier_complete(unsigned* bar, unsigned x, unsigned& nloc, unsigned& nx) {
    const unsigned G = gridDim.x * gridDim.y * gridDim.z;
    unsigned sum, cnt, mine, sp = 0u;
    for (;;) {
        sum = 0u; cnt = 0u; mine = 0u;
#pragma unroll
        for (unsigned j = 0; j < 16; ++j) { const unsigned c = xb_ld(&bar[XB_XCNT(j)]); sum += c; cnt += (c > 0u) ? 1u : 0u; mine = (j == x) ? c : mine; }
        if (sum == G) break;
        __builtin_amdgcn_s_sleep(1);
        if ((++sp & 255u) == 0u) { if (xb_ld(&bar[XB_TMO])) break; if (sp > XB_SPIN_CAP) { atomicAdd(&bar[XB_TMO], 1u); break; } }
    }
    nloc = mine > 0u ? mine : 1u; nx = cnt > 0u ? cnt : 1u;
}

__device__ __forceinline__ void xcd_barrier(const XcdBarrier& b) {
    asm volatile("s_waitcnt vmcnt(0)" ::: "memory");
    __syncthreads();
    if (threadIdx.x == 0) {
        unsigned* bar = b.bar;
        __builtin_amdgcn_s_waitcnt(0);
        unsigned nloc = b.st[0], nx = b.st[1];
        if (nloc == 0u) { xcd_barrier_complete(bar, b.x, nloc, nx); b.st[0] = nloc; b.st[1] = nx; }
        const unsigned old = xb_add(&bar[XB_XSUB(b.x)], 1u);
        const unsigned gen = old / nloc;
        if (old + 1u == (gen + 1u) * nloc) {
            __builtin_amdgcn_fence(__ATOMIC_RELEASE, "agent");
            asm volatile("s_waitcnt vmcnt(0)" ::: "memory");
            const unsigned og = xb_add(&bar[XB_TOP], 1u);
            const unsigned tg = og / nx;
            if (og + 1u == (tg + 1u) * nx) xb_add(&bar[XB_TOPGEN], 1u);
            else XB_SPIN(xb_ld(&bar[XB_TOPGEN]) == tg, bar);
            __builtin_amdgcn_fence(__ATOMIC_ACQUIRE, "agent");
            xb_add(&bar[XB_XGEN(b.x)], 1u);
            asm volatile("s_waitcnt vmcnt(0)" ::: "memory");
        } else {
            XB_SPIN(xb_ld(&bar[XB_XGEN(b.x)]) == gen, bar);
            __builtin_amdgcn_fence(__ATOMIC_ACQUIRE, "agent");
            asm volatile("s_waitcnt vmcnt(0)" ::: "memory");
        }
    }
    __syncthreads();
}

struct Args {
    const float* x; const int* pos; const float* ev_g_norm; const float* ev_w_in; const float* ev_g_q; const float* ev_g_k; const float* ev_g_kidx; const float* ev_g_vb;
    const float* ev_w_s; const float* ev_b_s; const float* ev_w_out; const float* od_g_norm; const float* od_w_pw1; const float* od_w_dw; const float* od_b_dw; const float* od_g_conv;
    const float* od_w_pw2; const float* ff_g_norm; const float* ff_w1; const float* ff_w2;
    float* out; unsigned char* ws;
    float invf64[32]; float invf32[16];
    int ph_lo, ph_hi;
};
struct Frame {
    LAS unsigned char* lds;
    volatile LAS unsigned* MISC;
    gu32* ctl;
    int tid, lane, wave;
    int vcu, G;
};

__device__ __forceinline__ float wave_sum(float v) {
#pragma unroll
    for (int o = 1; o < 64; o <<= 1) v += __shfl_xor(v, o);
    return v;
}
__device__ __forceinline__ float wave_max(float v) {
#pragma unroll
    for (int o = 1; o < 64; o <<= 1) v = fmaxf(v, __shfl_xor(v, o));
    return v;
}

__host__ __device__ __forceinline__ int in_src_col(int np) {
    const int pn = np >> 8, c = np & 255, bj = c >> 7, wc = (c >> 5) & 3, j = c & 31;
    if (pn < 2) return 64 * (4 * pn + wc) + 32 * bj + j;
    if (pn == 2) {
        if (wc == 0) return 512 + 32 * bj + j;
        if (wc == 1) return 576 + 32 * bj + j;
        if (wc == 2) { if (j < 16) return 896 + 16 * bj + j; if (bj == 0 && j < 24) return 928 + (j - 16); return -1; }
        return -1;
    }
    if (pn == 3) return 640 + 32 * (2 * wc + (j >> 4)) + 16 * bj + (j & 15);
    if (pn < 6) return 936 + 256 * (pn - 4) + c;
    return 1448 + 256 * (pn - 6) + c;
}
__host__ __device__ __forceinline__ int glu_src_col(int np) { const int pn = np >> 8, c = np & 255; return (c >> 7) * 1024 + 128 * pn + (c & 127); }

__device__ __forceinline__ void p0_transpose_item(const float* W, int K, int N, int NP, const float* gk, int mode, bf16* WT, LAS float* scr, int item, int lane) {
    const int nblk = NP / 32, kb = item / nblk, nb = item % nblk, k0 = 64 * kb, n0 = 32 * nb;
    const int np = n0 + (lane & 31);
    const int sc = mode == 0 ? np : (mode == 1 ? in_src_col(np) : glu_src_col(np));
#pragma unroll 8
    for (int i = 0; i < 32; ++i) { const int kk = 2 * i + (lane >> 5); float v = sc >= 0 ? W[(size_t)(k0 + kk) * N + sc] : 0.f; if (gk) v *= gk[k0 + kk]; scr[kk * 33 + (lane & 31)] = v; }
    LDS_WAIT(); asm volatile("" ::: "memory");
    const int c = lane & 7;
#pragma unroll
    for (int j = 0; j < 4; ++j) { const int n = (lane >> 3) + 8 * j; const LAS float* s = scr + (8 * c) * 33 + n;
        v4u o; o.x = pk2(s[0 * 33], s[1 * 33]); o.y = pk2(s[2 * 33], s[3 * 33]); o.z = pk2(s[4 * 33], s[5 * 33]); o.w = pk2(s[6 * 33], s[7 * 33]);
        *(GAS v4u*)(WT + (size_t)(n0 + n) * K + k0 + 8 * c) = o; }
    LDS_WAIT(); asm volatile("" ::: "memory");
}

__device__ __forceinline__ void sincos_acc(float ang, float& s, float& c) {
    const double a = (double)ang;
    const double q = __builtin_rint(a * 0.63661977236758134308);
    double r = __builtin_fma(-q, 1.57079632679489655800e+00, a);
    r = __builtin_fma(-q, 6.12323399573676603587e-17, r);
    const double r2 = r * r;
    double sp = 1.0 / 6227020800.0; sp = sp * r2 - 1.0 / 39916800.0; sp = sp * r2 + 1.0 / 362880.0; sp = sp * r2 - 1.0 / 5040.0; sp = sp * r2 + 1.0 / 120.0; sp = sp * r2 - 1.0 / 6.0; sp = sp * r2 * r + r;
    double cp = 1.0 / 479001600.0; cp = cp * r2 - 1.0 / 3628800.0; cp = cp * r2 + 1.0 / 40320.0; cp = cp * r2 - 1.0 / 720.0; cp = cp * r2 + 1.0 / 24.0; cp = cp * r2 - 0.5; cp = cp * r2 + 1.0;
    const int qi = (int)(long long)q & 3;
    const double ss = (qi & 1) ? cp : sp, cc = (qi & 1) ? sp : cp;
    s = (float)((qi & 2) ? -ss : ss);
    c = (float)(((qi + 1) & 2) ? -cc : cc);
}

__device__ __forceinline__ void p0_prologue(Frame& F, const Args& A) {
    unsigned char* ws = A.ws;
    LAS float* scr = (LAS float*)(F.lds + RING_OFF + F.wave * 16384);
    const int gw = F.vcu * NWAVES + F.wave, NGW = F.G * NWAVES;
    constexpr int I_IN = (D / 64) * (INWP / 32), I_OUT = (D / 64) * (D / 32), I_1 = (D / 64) * (FF / 32), I_2 = (FF / 64) * (D / 32), I_P1 = (D / 64) * (2 * D / 32), I_P2 = I_OUT;
    constexpr int NITEMS = I_IN + I_OUT + 2 * I_1 + 2 * I_2 + I_P1 + I_P2;
    for (int it = gw; it < NITEMS; it += NGW) {
        int r = it;
        if (r < I_IN) { p0_transpose_item(A.ev_w_in, D, INW, INWP, A.ev_g_norm, 1, (bf16*)(ws + WS_WIN), scr, r, F.lane); continue; } r -= I_IN;
        if (r < I_OUT) { p0_transpose_item(A.ev_w_out, D, D, D, nullptr, 0, (bf16*)(ws + WS_WOUT), scr, r, F.lane); continue; } r -= I_OUT;
        if (r < 2 * I_1) { const int l = r / I_1; p0_transpose_item(A.ff_w1 + (size_t)l * D * FF, D, FF, FF, A.ff_g_norm + l * D, 0, (bf16*)(ws + WS_W1) + (size_t)l * D * FF, scr, r % I_1, F.lane); continue; } r -= 2 * I_1;
        if (r < 2 * I_2) { const int l = r / I_2; p0_transpose_item(A.ff_w2 + (size_t)l * D * FF, FF, D, D, nullptr, 0, (bf16*)(ws + WS_W2) + (size_t)l * D * FF, scr, r % I_2, F.lane); continue; } r -= 2 * I_2;
        if (r < I_P1) { p0_transpose_item(A.od_w_pw1, D, 2 * D, 2 * D, A.od_g_norm, 2, (bf16*)(ws + WS_WPW1), scr, r, F.lane); continue; } r -= I_P1;
        p0_transpose_item(A.od_w_pw2, D, D, D, nullptr, 0, (bf16*)(ws + WS_WPW2), scr, r, F.lane);
    }
    bf16* XB = (bf16*)(ws + WS_XB); float* ssq = (float*)(ws + WS_SSQ);
    for (int m = gw; m < M; m += NGW) {
        const GAS f32x4* xr = (const GAS f32x4*)(A.x + (size_t)m * D) + F.lane;
        f32x4 v[4]; float s = 0.f;
#pragma unroll
        for (int j = 0; j < 4; ++j) { v[j] = xr[64 * j]; s += (v[j].x * v[j].x + v[j].y * v[j].y) + (v[j].z * v[j].z + v[j].w * v[j].w); }
        s = wave_sum(s);
        GAS unsigned long long* o8 = (GAS unsigned long long*)(XB + (size_t)m * D) + F.lane;
#pragma unroll
        for (int j = 0; j < 4; ++j) o8[64 * j] = (unsigned long long)pk2(v[j].x, v[j].y) | ((unsigned long long)pk2(v[j].z, v[j].w) << 32);
        if (F.lane < 16) ssq[(size_t)m * 16 + F.lane] = F.lane == 0 ? s : 0.f;
    }
    float* c64 = (float*)(ws + WS_COS64); float* s64 = (float*)(ws + WS_SIN64); float* c32 = (float*)(ws + WS_COS32); float* s32 = (float*)(ws + WS_SIN32);
    const int gt = F.vcu * (NWAVES * 64) + F.tid, NGT = F.G * NWAVES * 64;
    for (int e = gt; e < M * 32; e += NGT) { const int tok = e >> 5, i = e & 31; const float ang = (float)A.pos[tok] * A.invf64[i]; float s, c; sincos_acc(ang, s, c); c64[e] = c; s64[e] = s; }
    for (int e = gt; e < M * 16; e += NGT) { const int tok = e >> 4, i = e & 15; const float ang = (float)A.pos[tok] * A.invf32[i]; float s, c; sincos_acc(ang, s, c); c32[e] = c; s32[e] = s; }
}

__device__ __forceinline__ unsigned f2key(float f) { const unsigned u = __builtin_bit_cast(unsigned, f); return (u & 0x80000000u) ? ~u : (u | 0x80000000u); }

__device__ __forceinline__ void attn_simple_phase(Frame& F, const Args& A) {
    unsigned char* ws = A.ws;
    const bf16* Qg = (const bf16*)(ws + WS_Q); const bf16* Kb = (const bf16*)(ws + WS_KB); const bf16* Vb = (const bf16*)(ws + WS_VB);
    const float* Qi = (const float*)(ws + WS_QI); const float* Ki = (const float*)(ws + WS_KI); const float* Wi = (const float*)(ws + WS_WI);
    bf16* MIX = (bf16*)(ws + WS_MIX);
    LAS unsigned* keyL = (LAS unsigned*)(F.lds);
    LAS float* qiL = (LAS float*)(F.lds + 32768);
    LAS float* qL = (LAS float*)(F.lds + 32768 + 1024);
    LAS float* wiL = (LAS float*)(F.lds + 32768 + 3072);
    LAS unsigned* hist = (LAS unsigned*)(F.lds + 32768 + 4096);
    LAS int* sel = (LAS int*)(F.lds + 32768 + 5120);
    LAS float* lg = (LAS float*)(F.lds + 32768 + 6144);
    LAS unsigned* wtot = (LAS unsigned*)(F.lds + 32768 + 6144 + 8192);
    LAS unsigned* bc = (LAS unsigned*)(F.lds + 32768 + 6144 + 8192 + 64);
    const int tid = F.tid, lane = F.lane, wave = F.wave;
    for (int tok = F.vcu; tok < M; tok += F.G) {
        const int b = tok / SEQ, t = tok % SEQ, n = t + 1;
        const size_t kb0 = (size_t)b * SEQ;
        __syncthreads();
        if (tid < 256) qiL[tid] = Qi[(size_t)tok * 256 + tid];
        qL[tid] = bf2f(Qg[(size_t)tok * 512 + tid]);
        if (tid < 8) wiL[tid] = Wi[(size_t)tok * 8 + tid];
        __syncthreads();
        int nsel;
        if (n > TOPK) {
            for (int s = tid; s < n; s += NWAVES * 64) {
                asm volatile("" ::: "memory");
                const f32x4* kp = (const f32x4*)(Ki + (kb0 + s) * 32);
                f32x4 kv[8];
#pragma unroll
                for (int j = 0; j < 8; ++j) kv[j] = kp[j];
                float sc = 0.f;
#pragma unroll
                for (int h = 0; h < 8; ++h) {
                    float d = 0.f;
#pragma unroll
                    for (int j = 0; j < 8; ++j) { const f32x4 qv = *(const LAS f32x4*)(qiL + h * 32 + 4 * j); d += kv[j].x * qv.x; d += kv[j].y * qv.y; d += kv[j].z * qv.z; d += kv[j].w * qv.w; }
                    sc += wiL[h] * fmaxf(d, 0.f);
                }
                keyL[s] = f2key(sc);
            }
            unsigned prefix = 0u, mask = 0u, need = TOPK;
            for (int shift = 24; shift >= 0; shift -= 8) {
                if (tid < 256) hist[tid] = 0u;
                __syncthreads();
                for (int s = tid; s < n; s += NWAVES * 64) { const unsigned u = keyL[s]; if ((u & mask) == prefix) __hip_atomic_fetch_add(&hist[(u >> shift) & 255u], 1u, __ATOMIC_RELAXED, __HIP_MEMORY_SCOPE_WORKGROUP); }
                __syncthreads();
                if (wave == 0) {
                    const unsigned h0 = hist[4 * lane], h1 = hist[4 * lane + 1], h2 = hist[4 * lane + 2], h3 = hist[4 * lane + 3];
                    const unsigned c = h0 + h1 + h2 + h3;
                    unsigned sfx = c;
#pragma unroll
                    for (int o = 1; o < 64; o <<= 1) { const unsigned v = __shfl_down(sfx, o); if (lane + o < 64) sfx += v; }
                    const unsigned above = sfx - c;
                    if (above < need && sfx >= need) {
                        unsigned rem = need - above, dsel, cab;
                        if (h3 >= rem) { dsel = 3; cab = 0; } else if (h3 + h2 >= rem) { dsel = 2; cab = h3; } else if (h3 + h2 + h1 >= rem) { dsel = 1; cab = h3 + h2; } else { dsel = 0; cab = h3 + h2 + h1; }
                        bc[0] = 4 * lane + dsel; bc[1] = rem - cab;
                    }
                }
                __syncthreads();
                const unsigned dsel = bc[0]; need = bc[1];
                prefix |= dsel << shift; mask |= 255u << shift;
                __syncthreads();
            }
            const unsigned T = prefix, cgt = TOPK - need;
            unsigned run = 0u;
            for (int base = 0; base < n; base += NWAVES * 64) {
                const int s = base + tid; const unsigned u = s < n ? keyL[s] : 0u;
                const bool gt = s < n && u > T, eq = s < n && u == T;
                const unsigned long long bg = __ballot(gt), be = __ballot(eq);
                const unsigned long long lt = (1ull << lane) - 1ull;
                const unsigned pg = __popcll(bg & lt), pe = __popcll(be & lt);
                if (lane == 0) wtot[wave] = (unsigned)__popcll(bg) | ((unsigned)__popcll(be) << 16);
                __syncthreads();
                unsigned off = run, tot = 0u;
#pragma unroll
                for (int w = 0; w < NWAVES; ++w) { const unsigned v = wtot[w]; if (w < wave) off += v; tot += v; }
                if (gt) sel[(off & 0xffffu) + pg] = s;
                if (eq) { const unsigned rk = (off >> 16) + pe; if (rk < need) sel[cgt + rk] = s; }
                run += tot;
                __syncthreads();
            }
            nsel = TOPK;
        } else {
            if (tid < n) sel[tid] = tid;
            nsel = n;
        }
        __syncthreads();
        {
            const int j = tid & 255, hh = tid >> 8;
            float l0 = -INFINITY, l1 = -INFINITY, l2 = -INFINITY, l3 = -INFINITY;
            if (j < nsel) {
                const v4u* kp = (const v4u*)(Kb + (kb0 + sel[j]) * 64);
                l0 = l1 = l2 = l3 = 0.f;
#pragma unroll 1
                for (int c = 0; c < 8; ++c) {
                    asm volatile("" ::: "memory");
                    const v4u kw = kp[c];
                    const float k0 = bflo(kw.x), k1 = bfhi(kw.x), k2 = bflo(kw.y), k3 = bfhi(kw.y), k4 = bflo(kw.z), k5 = bfhi(kw.z), k6 = bflo(kw.w), k7 = bfhi(kw.w);
#pragma unroll
                    for (int h = 0; h < 4; ++h) {
                        const LAS float* qp = qL + (4 * hh + h) * 64 + 8 * c;
                        const f32x4 qa = *(const LAS f32x4*)qp, qb = *(const LAS f32x4*)(qp + 4);
                        const float d = (k0 * qa.x + k1 * qa.y) + (k2 * qa.z + k3 * qa.w) + (k4 * qb.x + k5 * qb.y) + (k6 * qb.z + k7 * qb.w);
                        if (h == 0) l0 += d; else if (h == 1) l1 += d; else if (h == 2) l2 += d; else l3 += d;
                    }
                }
            }
            lg[(4 * hh + 0) * 256 + j] = l0; lg[(4 * hh + 1) * 256 + j] = l1; lg[(4 * hh + 2) * 256 + j] = l2; lg[(4 * hh + 3) * 256 + j] = l3;
        }
        __syncthreads();
        {
            float v[4]; float mx = -INFINITY;
#pragma unroll
            for (int i = 0; i < 4; ++i) { v[i] = lg[wave * 256 + lane + 64 * i]; mx = fmaxf(mx, v[i]); }
            mx = wave_max(mx); float sm = 0.f;
#pragma unroll
            for (int i = 0; i < 4; ++i) { v[i] = __expf(v[i] - mx); sm += v[i]; }
            sm = wave_sum(sm); const float inv = 1.0f / sm;
#pragma unroll
            for (int i = 0; i < 4; ++i) lg[wave * 256 + lane + 64 * i] = v[i] * inv;
        }
        __syncthreads();
        {
            float o = 0.f;
#pragma unroll 4
            for (int j = 0; j < nsel; ++j) o += lg[wave * 256 + j] * bf2f(Vb[(kb0 + sel[j]) * 64 + lane]);
            MIX[(size_t)tok * 1024 + wave * 64 + lane] = (bf16)f2bf(o);
        }
    }
    __syncthreads();
}

__device__ __forceinline__ void gating_simple_phase(Frame& F, const Args& A) {
    unsigned char* ws = A.ws;
    const bf16* U = (const bf16*)(ws + WS_U); const bf16* VBg = (const bf16*)(ws + WS_VBG); const float* ssqv = (const float*)(ws + WS_SSQV);
    bf16* MIX = (bf16*)(ws + WS_MIX);
    LAS float* vv = (LAS float*)F.lds;
    const int tid = F.tid, lane = F.lane, wave = F.wave;
    for (int unit = F.vcu; unit < (M / CHUNK) * NG; unit += F.G) {
        const int c = unit >> 3, g = unit & 7; const size_t tok0 = (size_t)c * CHUNK;
        __syncthreads();
        for (int e = tid; e < CHUNK * GD; e += NWAVES * 64) {
            const int j = e >> 6, d = e & 63; const size_t tok = tok0 + j;
            const f32x4 a = *(const f32x4*)(ssqv + tok * 8), b2 = *(const f32x4*)(ssqv + tok * 8 + 4);
            const float ri = __builtin_amdgcn_rsqf((((a.x + a.y) + (a.z + a.w)) + ((b2.x + b2.y) + (b2.z + b2.w))) * (1.0f / 512.0f) + EPS);
            vv[e] = bf2f(VBg[tok * 512 + g * 64 + d]) * ri * A.ev_g_vb[g * 64 + d];
        }
        __syncthreads();
        const float* Wg = A.ev_w_s + (size_t)g * CHUNK * CHUNK;
        for (int r = 0; r < 16; ++r) {
            const int i = wave + 8 * r;
            const float* wrow = Wg + (size_t)i * CHUNK;
            float acc = 0.f;
            for (int j = 0; j <= i; ++j) acc += wrow[j] * vv[j * 64 + lane];
            const size_t tok = tok0 + i;
            const float sv = acc + A.ev_b_s[g * CHUNK + i];
            MIX[tok * 1024 + 512 + g * 64 + lane] = (bf16)f2bf(bf2f(U[tok * 512 + g * 64 + lane]) * sv);
        }
    }
    __syncthreads();
}

__device__ __forceinline__ void conv_simple_phase(Frame& F, const Args& A) {
    unsigned char* ws = A.ws;
    const bf16* Y = (const bf16*)(ws + WS_Y); bf16* YC = (bf16*)(ws + WS_YC);
    constexpr int TS = 16, ROWS = TS + CW - 1;
    LAS unsigned* yl = (LAS unsigned*)F.lds;
    LAS float* part = (LAS float*)(F.lds + ROWS * 2048);
    const int tid = F.tid, lane = F.lane, wave = F.wave;
    float w0[CW], w1[CW];
#pragma unroll
    for (int k = 0; k < CW; ++k) { w0[k] = A.od_w_dw[k * D + 2 * tid]; w1[k] = A.od_w_dw[k * D + 2 * tid + 1]; }
    const float b0 = A.od_b_dw[2 * tid], b1 = A.od_b_dw[2 * tid + 1], g0 = A.od_g_conv[2 * tid], g1 = A.od_g_conv[2 * tid + 1];
    for (int strip = F.vcu; strip < M / TS; strip += F.G) {
        const int tok0 = strip * TS, s0 = tok0 % SEQ;
        __syncthreads();
        for (int r = 0; r < ROWS; ++r) { const int s = s0 - (CW - 1) + r; yl[r * 512 + tid] = s >= 0 ? *(const unsigned*)(Y + (size_t)(tok0 - (CW - 1) + r) * D + 2 * tid) : 0u; }
        __syncthreads();
        float o0[TS], o1[TS];
#pragma unroll
        for (int tk = 0; tk < TS; ++tk) {
            float a0 = b0, a1 = b1;
#pragma unroll
            for (int k = 0; k < CW; ++k) { const unsigned w = yl[(tk + k) * 512 + tid]; a0 += w0[k] * bflo(w); a1 += w1[k] * bfhi(w); }
            o0[tk] = a0; o1[tk] = a1;
            const float ss = wave_sum(a0 * a0 + a1 * a1);
            if (lane == 0) part[tk * 8 + wave] = ss;
        }
        __syncthreads();
#pragma unroll
        for (int tk = 0; tk < TS; ++tk) {
            const f32x4 pa = *(const LAS f32x4*)(part + tk * 8), pb = *(const LAS f32x4*)(part + tk * 8 + 4);
            const float ri = __builtin_amdgcn_rsqf((((pa.x + pa.y) + (pa.z + pa.w)) + ((pb.x + pb.y) + (pb.z + pb.w))) * (1.0f / 1024.0f) + EPS);
            const float y0 = o0[tk] * ri * g0, y1 = o1[tk] * ri * g1;
            const float z0 = y0 * __builtin_amdgcn_rcpf(1.0f + __builtin_amdgcn_exp2f(y0 * -1.4426950408889634f)), z1 = y1 * __builtin_amdgcn_rcpf(1.0f + __builtin_amdgcn_exp2f(y1 * -1.4426950408889634f));
            *(unsigned*)(YC + (size_t)(tok0 + tk) * D + 2 * tid) = pk2(z0, z1);
        }
    }
    __syncthreads();
}

__global__ void __launch_bounds__(NWAVES * 64, 2) mk_fwd(Args args) {
    extern __shared__ __attribute__((aligned(16))) unsigned char lds[];
    Frame F;
    F.lds = (LAS unsigned char*)lds;
    F.MISC = (volatile LAS unsigned*)(F.lds + MISC_OFF);
    F.tid = threadIdx.x; F.lane = F.tid & 63; F.wave = __builtin_amdgcn_readfirstlane(F.tid >> 6);
    F.G = gridDim.x; { const int bx = blockIdx.x; F.vcu = (F.G % 8 == 0) ? (bx % 8) * (F.G / 8) + bx / 8 : bx; }
    unsigned char* ws = args.ws;
    F.ctl = (gu32*)(ws + WS_CTL);
    for (int u = F.tid; u < (LDS_BYTES - LDSCTL_OFF) / 4; u += NWAVES * 64) ((LAS unsigned*)(F.lds + LDSCTL_OFF))[u] = 0u;
    __syncthreads();
#if MK_ONE_LAUNCH
    XcdBarrier bar = xcd_barrier_post((unsigned*)(F.ctl + CW_BAR), F.MISC + 8);
#define GRID_BAR() xcd_barrier(bar)
#else
#define GRID_BAR() do {} while (0)
#endif
    const int lo = args.ph_lo, hi = args.ph_hi;
#ifndef PH_MASK
#define PH_MASK 0x7ff
#endif
#define IN(k) (((PH_MASK >> (k)) & 1) && lo <= (k) && (k) < hi)
#define SEAM(k) do { if (IN(k) && IN((k) + 1)) GRID_BAR(); __builtin_amdgcn_sched_barrier(0); asm volatile("" ::: "memory"); } while (0)
    using pg8::bf16_t;
    bf16_t* XB = (bf16_t*)(ws + WS_XB); float* SSQ = (float*)(ws + WS_SSQ);

    if (IN(0)) { p0_prologue(F, args); } SEAM(0);
    if (IN(1)) {
        pg8::Gemm g{XB, (const bf16_t*)(ws + WS_WIN), M, INWP, D}; pg8::StaticOrder S; S.init(M, INWP, F.G, (int)blockIdx.x);
        pg8::EpiIn E{SSQ, (const float*)(ws + WS_COS64), (const float*)(ws + WS_SIN64), (const float*)(ws + WS_COS32), (const float*)(ws + WS_SIN32), args.ev_g_q, args.ev_g_k, args.ev_g_kidx,
                     (bf16_t*)(ws + WS_Q), (bf16_t*)(ws + WS_KB), (bf16_t*)(ws + WS_VB), (float*)(ws + WS_QI), (float*)(ws + WS_KI), (float*)(ws + WS_WI), (bf16_t*)(ws + WS_U), (bf16_t*)(ws + WS_VBG), (float*)(ws + WS_SSQV)};
        pg8::gemm_phase<pg8::EpiIn, pg8::StaticOrder, true, true>(F.lds + RING_OFF, g, S, E);
    } SEAM(1);
    if (IN(2)) {
#ifndef NO_ATTN
        attn_simple_phase(F, args);
#endif
#ifndef NO_GATE
        gating_simple_phase(F, args);
#endif
    } SEAM(2);
    if (IN(3)) {
        pg8::Gemm g{(const bf16_t*)(ws + WS_MIX), (const bf16_t*)(ws + WS_WOUT), M, D, D}; pg8::StaticOrder S; S.init(M, D, F.G, (int)blockIdx.x);
        pg8::EpiRes E{args.x, args.out, XB, SSQ};
        pg8::gemm_phase<pg8::EpiRes, pg8::StaticOrder, true, true>(F.lds + RING_OFF, g, S, E);
    } SEAM(3);
    if (IN(4)) {
        pg8::Gemm g{XB, (const bf16_t*)(ws + WS_W1), M, FF, D}; pg8::StaticOrder S; S.init(M, FF, F.G, (int)blockIdx.x);
        pg8::EpiUp E{SSQ, (bf16_t*)(ws + WS_BIG), FF};
        pg8::gemm_phase<pg8::EpiUp, pg8::StaticOrder, true, true>(F.lds + RING_OFF, g, S, E);
    } SEAM(4);
    if (IN(5)) {
        pg8::Gemm g{(const bf16_t*)(ws + WS_BIG), (const bf16_t*)(ws + WS_W2), M, D, FF}; pg8::StaticOrder S; S.init(M, D, F.G, (int)blockIdx.x);
        pg8::EpiRes E{args.out, args.out, XB, SSQ};
        pg8::gemm_phase<pg8::EpiRes, pg8::StaticOrder, true, true>(F.lds + RING_OFF, g, S, E);
    } SEAM(5);
    if (IN(6)) {
        pg8::Gemm g{XB, (const bf16_t*)(ws + WS_WPW1), M, 2 * D, D}; pg8::StaticOrder S; S.init(M, 2 * D, F.G, (int)blockIdx.x);
        pg8::EpiGlu E{SSQ, (bf16_t*)(ws + WS_Y)};
        pg8::gemm_phase<pg8::EpiGlu, pg8::StaticOrder, true, true>(F.lds + RING_OFF, g, S, E);
    } SEAM(6);
    if (IN(7)) { conv_simple_phase(F, args); } SEAM(7);
    if (IN(8)) {
        pg8::Gemm g{(const bf16_t*)(ws + WS_YC), (const bf16_t*)(ws + WS_WPW2), M, D, D}; pg8::StaticOrder S; S.init(M, D, F.G, (int)blockIdx.x);
        pg8::EpiRes E{args.out, args.out, XB, SSQ};
        pg8::gemm_phase<pg8::EpiRes, pg8::StaticOrder, true, true>(F.lds + RING_OFF, g, S, E);
    } SEAM(8);
    if (IN(9)) {
        pg8::Gemm g{XB, (const bf16_t*)(ws + WS_W1) + (size_t)D * FF, M, FF, D}; pg8::StaticOrder S; S.init(M, FF, F.G, (int)blockIdx.x);
        pg8::EpiUp E{SSQ, (bf16_t*)(ws + WS_HID1), FF};
        pg8::gemm_phase<pg8::EpiUp, pg8::StaticOrder, true, true>(F.lds + RING_OFF, g, S, E);
    } SEAM(9);
    if (IN(10)) {
        pg8::Gemm g{(const bf16_t*)(ws + WS_HID1), (const bf16_t*)(ws + WS_W2) + (size_t)D * FF, M, D, FF}; pg8::StaticOrder S; S.init(M, D, F.G, (int)blockIdx.x);
        pg8::EpiRes E{args.out, args.out, nullptr, nullptr};
        pg8::gemm_phase<pg8::EpiRes, pg8::StaticOrder, true, true>(F.lds + RING_OFF, g, S, E);
    }
#undef IN
#undef SEAM
}

extern "C" void kernel_launch(void* const* d_in, const int* in_sizes, int n_in, void* d_out, int out_size, void* d_ws, size_t ws_size, hipStream_t stream) {
    static int grid = 0;
    if (grid == 0) {
        if (n_in != 20 || in_sizes[0] != M * D || out_size != M * D || ws_size < WS_END) { fprintf(stderr, "kernel_launch: unexpected problem shape (n_in %d, in0 %d, out %d, ws %zu < %zu); nothing launched\n", n_in, n_in > 0 ? in_sizes[0] : -1, out_size, ws_size, (size_t)WS_END); grid = -1; return; }
        int dev = 0, cus = 0, per_cu = 0;
        if (hipGetDevice(&dev) != hipSuccess || hipDeviceGetAttribute(&cus, hipDeviceAttributeMultiprocessorCount, dev) != hipSuccess) { grid = -1; return; }
        if (hipFuncSetAttribute((const void*)mk_fwd, hipFuncAttributeMaxDynamicSharedMemorySize, LDS_BYTES) != hipSuccess) { fprintf(stderr, "kernel_launch: hipFuncSetAttribute failed\n"); grid = -1; return; }
        if (hipOccupancyMaxActiveBlocksPerMultiprocessor(&per_cu, (const void*)mk_fwd, NWAVES * 64, LDS_BYTES) != hipSuccess || per_cu < 1) { fprintf(stderr, "kernel_launch: occupancy query says %d blocks per CU\n", per_cu); per_cu = 1; }
        (void)hipGetLastError();
        grid = cus;
    }
    if (grid < 0) return;
    (void)hipMemsetAsync((char*)d_ws + WS_CTL, 0, CTL_ZERO_BYTES, stream);
    Args a{};
    a.x = (const float*)d_in[0]; a.pos = (const int*)d_in[1]; a.ev_g_norm = (const float*)d_in[2]; a.ev_w_in = (const float*)d_in[3]; a.ev_g_q = (const float*)d_in[4]; a.ev_g_k = (const float*)d_in[5];
    a.ev_g_kidx = (const float*)d_in[6]; a.ev_g_vb = (const float*)d_in[7]; a.ev_w_s = (const float*)d_in[8]; a.ev_b_s = (const float*)d_in[9]; a.ev_w_out = (const float*)d_in[10];
    a.od_g_norm = (const float*)d_in[11]; a.od_w_pw1 = (const float*)d_in[12]; a.od_w_dw = (const float*)d_in[13]; a.od_b_dw = (const float*)d_in[14]; a.od_g_conv = (const float*)d_in[15]; a.od_w_pw2 = (const float*)d_in[16];
    a.ff_g_norm = (const float*)d_in[17]; a.ff_w1 = (const float*)d_in[18]; a.ff_w2 = (const float*)d_in[19];
    a.out = (float*)d_out; a.ws = (unsigned char*)d_ws;
    for (int i = 0; i < 32; ++i) a.invf64[i] = powf(10000.0f, -(float)i * 2.0f / 64.0f);
    for (int i = 0; i < 16; ++i) a.invf32[i] = powf(10000.0f, -(float)i * 2.0f / 32.0f);
#if MK_ONE_LAUNCH
    a.ph_lo = 0; a.ph_hi = N_PHASES;
    void* kargs[] = {&a};
    hipError_t e = hipLaunchCooperativeKernel((const void*)mk_fwd, dim3(grid), dim3(NWAVES * 64), kargs, LDS_BYTES, stream);
    if (e != hipSuccess) fprintf(stderr, "kernel_launch: cooperative launch failed: %s (grid %d)\n", hipGetErrorString(e), grid);
#else
    for (int p = 0; p < N_PHASES; ++p) {
        a.ph_lo = p; a.ph_hi = p + 1;
        hipLaunchKernelGGL(mk_fwd, dim3(grid), dim3(NWAVES * 64), LDS_BYTES, stream, a);
    }
#endif
}
```

```cpp
#include <hip/hip_runtime.h>
#include <cstdio>
#include <cstdint>
#include <cmath>
namespace pg8 {
#define PG8_LAS __attribute__((address_space(3)))
typedef unsigned short bf16_t;
typedef short bf16x8 __attribute__((ext_vector_type(8)));
typedef float f32x4 __attribute__((ext_vector_type(4)));
typedef unsigned u32x4 __attribute__((ext_vector_type(4)));
constexpr int BM = 256, BK = 64, HALF = 128, HTB = HALF * BK * 2  , STAGE_BYTES = 8 * HTB, NXCD = 8, WGM = 8;

__host__ __device__ __forceinline__ int lds_byte(int r, int c) { const int st = (r >> 4) * 2 + (c >> 5), rr = r & 15, cc = c & 31, ob = rr * 64 + cc * 2; return st * 1024 + (ob ^ (((ob >> 9) & 1) << 5)); }
__host__ __device__ __forceinline__ void stage_rc(int b, int& R, int& C) { const int st = b / 1024, sb = b % 1024, swz = sb ^ (((sb >> 9) & 1) << 5); R = (st >> 1) * 16 + swz / 64; C = (st & 1) * 32 + (swz % 64) / 2; }
__host__ __device__ __forceinline__ int perm32(int rho) { const int n = rho >> 4, i = rho & 15; return 8 * (i >> 2) + 4 * n + (i & 3); }

struct Unit { int pm, pn; };
struct Gemm { const bf16_t* A; const bf16_t* Bt; int M, N, K; };

struct StaticOrder {
    int nM, nN, nwg, G, c;
    __host__ __device__ void init(int M, int N, int G_, int c_) { nM = M / BM; nN = N / BM; nwg = nM * nN; G = G_; c = c_; }
    __host__ __device__ bool next(int i, Unit& u) const {
        const long L = (long)i * G + c; if (L >= nwg) return false;
        int wgid = (int)L; { const int q = nwg / NXCD, r = nwg % NXCD, xcd = wgid % NXCD, off = wgid / NXCD; wgid = (xcd < r ? xcd * (q + 1) : r * (q + 1) + (xcd - r) * q) + off; }
        const int nig = WGM * nN, gid = wgid / nig, fm = gid * WGM, gsz = (nM - fm) < WGM ? (nM - fm) : WGM;
        u.pm = fm + ((wgid % nig) % gsz); u.pn = (wgid % nig) / gsz; return true;
    }
    __device__ __forceinline__ void a_ready(const Unit&) const {}
    __device__ __forceinline__ void done(const Unit&) const {}
};

__device__ __forceinline__ unsigned cvt_pk_bf16(float lo, float hi) { unsigned r; asm volatile("v_cvt_pk_bf16_f32 %0, %1, %2" : "=v"(r) : "v"(lo), "v"(hi)); return r; }
typedef unsigned u32x2 __attribute__((ext_vector_type(2)));
constexpr float RMS_EPS = 1e-6f;
__device__ __forceinline__ float dot4(const f32x4 a) { return (a[0] * a[0] + a[1] * a[1]) + (a[2] * a[2] + a[3] * a[3]); }
__device__ __forceinline__ float row_rinv(const float* ssq, int row) {
    const f32x4* p = (const f32x4*)(ssq + (size_t)row * 16);
    const f32x4 a = p[0], b = p[1], c = p[2], d = p[3];
    const float s = ((a[0] + a[1]) + (a[2] + a[3])) + ((b[0] + b[1]) + (b[2] + b[3])) + ((c[0] + c[1]) + (c[2] + c[3])) + ((d[0] + d[1]) + (d[2] + d[3]));
    return __builtin_amdgcn_rsqf(s * (1.0f / 1024.0f) + RMS_EPS);
}
__device__ __forceinline__ float gelu_tanh1(float x) {
    const float t = x * (0.7978845608028654f + 0.035677408136300125f * x * x);
    const float e = __builtin_amdgcn_exp2f(t * -2.8853900817779268f);
    return x * __builtin_amdgcn_rcpf(1.0f + e);
}
__device__ __forceinline__ f32x4 gelu4(const f32x4 v) { return (f32x4){gelu_tanh1(v[0]), gelu_tanh1(v[1]), gelu_tanh1(v[2]), gelu_tanh1(v[3])}; }
__device__ __forceinline__ void st_bf16x4(bf16_t* p, const f32x4 v) { u32x2 w; w.x = cvt_pk_bf16(v[0], v[1]); w.y = cvt_pk_bf16(v[2], v[3]); *(u32x2*)p = w; }

struct EpiIn {
    static constexpr bool PERM = false, AFTER_DRAIN = false;
    const float* ssq; const float* cos64; const float* sin64; const float* cos32; const float* sin32;
    const float* gq; const float* gk; const float* gki;
    bf16_t* Q; bf16_t* Kb; bf16_t* Vb; float* Qi; float* Ki; float* Wi; bf16_t* U; bf16_t* VBg; float* ssqv;
    __device__ __forceinline__ void operator()(const f32x4 (&acc)[2][2][4][2], const Unit& u, int wr, int wc, int fr, int fq) const {
        const int pn = u.pn;
        const int rowb = u.pm * BM + wr * 64 + fr;
        if (pn < 2 || (pn == 2 && wc == 0)) {
            const float* g = pn < 2 ? gq : gk;
            const f32x4 g00 = *(const f32x4*)(g + 4 * fq), g01 = *(const f32x4*)(g + 16 + 4 * fq), g10 = *(const f32x4*)(g + 32 + 4 * fq), g11 = *(const f32x4*)(g + 48 + 4 * fq);
            const float osc = pn < 2 ? 0.125f : 1.0f;
#pragma unroll
            for (int ai = 0; ai < 2; ++ai)
#pragma unroll
                for (int m = 0; m < 4; ++m) {
                    const int row = rowb + ai * HALF + m * 16; const float ri = row_rinv(ssq, row);
                    const f32x4 v00 = acc[ai][0][m][0] * ri, v01 = acc[ai][0][m][1] * ri, v10 = acc[ai][1][m][0] * ri, v11 = acc[ai][1][m][1] * ri;
                    float ss = (dot4(v00) + dot4(v01)) + (dot4(v10) + dot4(v11));
                    ss += __shfl_xor(ss, 16); ss += __shfl_xor(ss, 32);
                    const float rn = __builtin_amdgcn_rsqf(ss * (1.0f / 64.0f) + RMS_EPS) * osc;
                    const f32x4 y00 = v00 * rn * g00, y01 = v01 * rn * g01, y10 = v10 * rn * g10, y11 = v11 * rn * g11;
                    const f32x4 c0 = *(const f32x4*)(cos64 + (size_t)row * 32 + 4 * fq), c1 = *(const f32x4*)(cos64 + (size_t)row * 32 + 16 + 4 * fq);
                    const f32x4 s0 = *(const f32x4*)(sin64 + (size_t)row * 32 + 4 * fq), s1 = *(const f32x4*)(sin64 + (size_t)row * 32 + 16 + 4 * fq);
                    const f32x4 o00 = y00 * c0 - y10 * s0, o10 = y10 * c0 + y00 * s0, o01 = y01 * c1 - y11 * s1, o11 = y11 * c1 + y01 * s1;
                    bf16_t* dst = pn < 2 ? Q + (size_t)row * 512 + (4 * pn + wc) * 64 + 4 * fq : Kb + (size_t)row * 64 + 4 * fq;
                    st_bf16x4(dst, o00); st_bf16x4(dst + 16, o01); st_bf16x4(dst + 32, o10); st_bf16x4(dst + 48, o11);
                }
        } else if (pn == 2) {
            if (wc == 1) {
#pragma unroll
                for (int ai = 0; ai < 2; ++ai)
#pragma unroll
                    for (int m = 0; m < 4; ++m) {
                        const int row = rowb + ai * HALF + m * 16; const float ri = row_rinv(ssq, row);
                        bf16_t* dst = Vb + (size_t)row * 64 + 4 * fq;
                        st_bf16x4(dst, acc[ai][0][m][0] * ri); st_bf16x4(dst + 16, acc[ai][0][m][1] * ri); st_bf16x4(dst + 32, acc[ai][1][m][0] * ri); st_bf16x4(dst + 48, acc[ai][1][m][1] * ri);
                    }
            } else if (wc == 2) {
                const f32x4 g0 = *(const f32x4*)(gki + 4 * fq), g1 = *(const f32x4*)(gki + 16 + 4 * fq);
#pragma unroll
                for (int ai = 0; ai < 2; ++ai)
#pragma unroll
                    for (int m = 0; m < 4; ++m) {
                        const int row = rowb + ai * HALF + m * 16; const float ri = row_rinv(ssq, row);
                        const f32x4 v0 = acc[ai][0][m][0] * ri, v1 = acc[ai][1][m][0] * ri;
                        float ss = dot4(v0) + dot4(v1);
                        ss += __shfl_xor(ss, 16); ss += __shfl_xor(ss, 32);
                        const float rn = __builtin_amdgcn_rsqf(ss * (1.0f / 32.0f) + RMS_EPS);
                        const f32x4 y0 = v0 * rn * g0, y1 = v1 * rn * g1;
                        const f32x4 c = *(const f32x4*)(cos32 + (size_t)row * 16 + 4 * fq), s = *(const f32x4*)(sin32 + (size_t)row * 16 + 4 * fq);
                        *(f32x4*)(Ki + (size_t)row * 32 + 4 * fq) = y0 * c - y1 * s;
                        *(f32x4*)(Ki + (size_t)row * 32 + 16 + 4 * fq) = y1 * c + y0 * s;
                        if (fq < 2) *(f32x4*)(Wi + (size_t)row * 8 + 4 * fq) = acc[ai][0][m][1] * (ri * 0.0625f);
                    }
            }
        } else if (pn == 3) {
#pragma unroll
            for (int ai = 0; ai < 2; ++ai)
#pragma unroll
                for (int m = 0; m < 4; ++m) {
                    const int row = rowb + ai * HALF + m * 16; const float ri = row_rinv(ssq, row);
                    const f32x4 c = *(const f32x4*)(cos32 + (size_t)row * 16 + 4 * fq), s = *(const f32x4*)(sin32 + (size_t)row * 16 + 4 * fq);
#pragma unroll
                    for (int n = 0; n < 2; ++n) {
                        const f32x4 x1 = acc[ai][0][m][n] * ri, x2 = acc[ai][1][m][n] * ri;
                        float* dst = Qi + (size_t)row * 256 + (2 * wc + n) * 32 + 4 * fq;
                        *(f32x4*)dst = x1 * c - x2 * s; *(f32x4*)(dst + 16) = x2 * c + x1 * s;
                    }
                }
        } else {
            const bool isv = pn >= 6;
            bf16_t* O = isv ? VBg : U; const int colt = (pn & 1) * 256 + wc * 32 + 4 * fq;
#pragma unroll
            for (int ai = 0; ai < 2; ++ai)
#pragma unroll
                for (int m = 0; m < 4; ++m) {
                    const int row = rowb + ai * HALF + m * 16; const float ri = row_rinv(ssq, row);
                    float ss = 0.f;
#pragma unroll
                    for (int bj = 0; bj < 2; ++bj)
#pragma unroll
                        for (int n = 0; n < 2; ++n) { const f32x4 gv = gelu4(acc[ai][bj][m][n] * ri); ss += dot4(gv); st_bf16x4(O + (size_t)row * 512 + colt + bj * HALF + n * 16, gv); }
                    if (isv) { ss += __shfl_xor(ss, 16); ss += __shfl_xor(ss, 32); if (fq == 0) ssqv[(size_t)row * 8 + (pn - 6) * 4 + wc] = ss; }
                }
        }
    }
};
struct EpiRes {
    static constexpr bool PERM = false, AFTER_DRAIN = false;
    const float* base; float* out; bf16_t* xb; float* ssq;
    __device__ __forceinline__ void operator()(const f32x4 (&acc)[2][2][4][2], const Unit& u, int wr, int wc, int fr, int fq) const {
        const int rowb = u.pm * BM + wr * 64 + fr, col0 = u.pn * BM + wc * 32 + 4 * fq;
#pragma unroll
        for (int ai = 0; ai < 2; ++ai)
#pragma unroll
            for (int m = 0; m < 4; ++m) {
                const int row = rowb + ai * HALF + m * 16; const size_t off = (size_t)row * 1024 + col0; float ss = 0.f;
#pragma unroll
                for (int bj = 0; bj < 2; ++bj)
#pragma unroll
                    for (int n = 0; n < 2; ++n) { const size_t o2 = off + bj * HALF + n * 16; const f32x4 o = *(const f32x4*)(base + o2) + acc[ai][bj][m][n]; *(f32x4*)(out + o2) = o; ss += dot4(o); if (xb) st_bf16x4(xb + o2, o); }
                if (ssq) { ss += __shfl_xor(ss, 16); ss += __shfl_xor(ss, 32); if (fq == 0) ssq[(size_t)row * 16 + u.pn * 4 + wc] = ss; }
            }
    }
};
struct EpiUp {
    static constexpr bool PERM = true, AFTER_DRAIN = false;
    const float* ssq; bf16_t* O; int ldc;
    __device__ __forceinline__ void operator()(const f32x4 (&acc)[2][2][4][2], const Unit& u, int wr, int wc, int fr, int fq) const {
        const int rowb = u.pm * BM + wr * 64 + fr, col0 = u.pn * BM + wc * 32 + 8 * fq;
#pragma unroll
        for (int ai = 0; ai < 2; ++ai)
#pragma unroll
            for (int m = 0; m < 4; ++m) {
                const int row = rowb + ai * HALF + m * 16; const float ri = row_rinv(ssq, row); bf16_t* rowp = O + (size_t)row * ldc + col0;
#pragma unroll
                for (int bj = 0; bj < 2; ++bj) {
                    f32x4 v0 = acc[ai][bj][m][0] * ri, v1 = acc[ai][bj][m][1] * ri;
#pragma unroll
                    for (int i = 0; i < 4; ++i) { const float a = fmaxf(v0[i], 0.f), b = fmaxf(v1[i], 0.f); v0[i] = a * a; v1[i] = b * b; }
                    u32x4 w; w.x = cvt_pk_bf16(v0[0], v0[1]); w.y = cvt_pk_bf16(v0[2], v0[3]); w.z = cvt_pk_bf16(v1[0], v1[1]); w.w = cvt_pk_bf16(v1[2], v1[3]);
                    *(u32x4*)(rowp + bj * HALF) = w;
                }
            }
    }
};
struct EpiGlu {
    static constexpr bool PERM = false, AFTER_DRAIN = false;
    const float* ssq; bf16_t* Y;
    __device__ __forceinline__ void operator()(const f32x4 (&acc)[2][2][4][2], const Unit& u, int wr, int wc, int fr, int fq) const {
        const int rowb = u.pm * BM + wr * 64 + fr, col0 = u.pn * HALF + wc * 32 + 4 * fq;
#pragma unroll
        for (int ai = 0; ai < 2; ++ai)
#pragma unroll
            for (int m = 0; m < 4; ++m) {
                const int row = rowb + ai * HALF + m * 16; const float ri = row_rinv(ssq, row);
#pragma unroll
                for (int n = 0; n < 2; ++n) {
                    const f32x4 a = acc[ai][0][m][n] * ri, b = acc[ai][1][m][n] * ri; f32x4 y;
#pragma unroll
                    for (int i = 0; i < 4; ++i) y[i] = a[i] * __builtin_amdgcn_rcpf(1.0f + __builtin_amdgcn_exp2f(b[i] * -1.4426950408889634f));
                    st_bf16x4(Y + (size_t)row * 1024 + col0 + n * 16, y);
                }
            }
    }
};
template <class Epi, class Sched, bool ALIGN_EPI = false, bool SP2 = false>
__device__ __forceinline__ void gemm_phase(PG8_LAS unsigned char* lds, const Gemm g, const Sched& S, const Epi& E) {
    const int tid = threadIdx.x, wid = __builtin_amdgcn_readfirstlane(tid >> 6), lane = tid & 63, wr = wid >> 2, wc = wid & 3, fr = lane & 15, fq = lane >> 4;
    const int K = g.K, nt = K / BK;
    unsigned voffA[2], voffB[2];
#pragma unroll
    for (int i = 0; i < 2; ++i) { int R, C; stage_rc(tid * 16 + i * 8192, R, C); const int Rb = Epi::PERM ? ((R & ~31) + perm32(R & 31)) : R;
        voffA[i] = (unsigned)(R * K + C) * 2u; voffB[i] = (unsigned)(Rb * K + C) * 2u; }
    const size_t kstep = (size_t)(BK * 2);
    const size_t hstep = (size_t)HALF * K * 2;
    const size_t tstep = 2 * hstep;
    const unsigned ldsw = (unsigned)wid * 1024u;
    const int aoff = lds_byte(wr * 64 + fr, fq * 8), boff = lds_byte(wc * 32 + fr, fq * 8);
#define PG8_SA(b, h) (((b) * 2 + (h)) * HTB)
#define PG8_SB(b, h) ((4 + (b) * 2 + (h)) * HTB)
#define PG8_STAGE(bufoff, gbase, voff) do { _Pragma("unroll") for (int _i = 0; _i < 2; ++_i) \
        __builtin_amdgcn_global_load_lds((const unsigned*)((const char*)(gbase) + (voff)[_i]), (PG8_LAS unsigned*)(lds + (bufoff) + ldsw + _i * 8192), 16, 0, 0); } while (0)
#define PG8_LDA(dst, b, h) do { _Pragma("unroll") for (int m = 0; m < 4; ++m) _Pragma("unroll") for (int k = 0; k < 2; ++k) dst[m][k] = *(const PG8_LAS bf16x8*)(lds + PG8_SA(b, h) + aoff + m * 2048 + k * 1024); } while (0)
#define PG8_LDB(dst, b, h) do { _Pragma("unroll") for (int n = 0; n < 2; ++n) _Pragma("unroll") for (int k = 0; k < 2; ++k) dst[n][k] = *(const PG8_LAS bf16x8*)(lds + PG8_SB(b, h) + boff + n * 2048 + k * 1024); } while (0)
#define PG8_MMA(ai, bj, At, Bt) do { __builtin_amdgcn_s_setprio(1); _Pragma("unroll") for (int m = 0; m < 4; ++m) _Pragma("unroll") for (int n = 0; n < 2; ++n) _Pragma("unroll") for (int k = 0; k < 2; ++k) \
        acc[ai][bj][m][n] = __builtin_amdgcn_mfma_f32_16x16x32_bf16(Bt[n][k], At[m][k], acc[ai][bj][m][n], 0, 0, 0); __builtin_amdgcn_s_setprio(0); } while (0)
#define PG8_WAIT_V(n) asm volatile("s_waitcnt vmcnt(" #n ")" ::: "memory")
#define PG8_WAIT_L(n) asm volatile("s_waitcnt lgkmcnt(" #n ")" ::: "memory")
#define PG8_BAR __builtin_amdgcn_s_barrier()
#define PG8_SCHED __builtin_amdgcn_sched_barrier(0)
    Unit cur, nxt; int ui = 0;
    if (!S.next(0, cur)) return;
    f32x4 acc[2][2][4][2];
#pragma unroll
    for (int a = 0; a < 2; ++a)
#pragma unroll
        for (int b = 0; b < 2; ++b)
#pragma unroll
            for (int m = 0; m < 4; ++m)
#pragma unroll
                for (int n = 0; n < 2; ++n) acc[a][b][m][n] = (f32x4){0.f, 0.f, 0.f, 0.f};
    bf16x8 At[4][2], B0[2][2], B1[2][2];
    const char* cA = (const char*)g.A + (size_t)cur.pm * tstep; const char* cB = (const char*)g.Bt + (size_t)cur.pn * tstep;
    S.a_ready(cur);
    if constexpr (SP2) {
        PG8_STAGE(PG8_SB(0, 0), cB, voffB); PG8_STAGE(PG8_SB(0, 1), cB + hstep, voffB); PG8_STAGE(PG8_SA(0, 0), cA, voffA); PG8_STAGE(PG8_SA(0, 1), cA + hstep, voffA);
        if (wr == 1) PG8_BAR;
        PG8_WAIT_V(2); PG8_BAR;
        PG8_STAGE(PG8_SB(1, 0), cB + kstep, voffB); PG8_STAGE(PG8_SA(1, 0), cA + kstep, voffA); PG8_STAGE(PG8_SB(1, 1), cB + hstep + kstep, voffB);
        PG8_WAIT_V(6); PG8_BAR;
    } else {
        PG8_STAGE(PG8_SB(0, 0), cB, voffB); PG8_STAGE(PG8_SA(0, 0), cA, voffA); PG8_STAGE(PG8_SB(0, 1), cB + hstep, voffB); PG8_STAGE(PG8_SA(0, 1), cA + hstep, voffA);
        if (wr == 1) PG8_BAR;
        PG8_WAIT_V(4); PG8_BAR;
        PG8_STAGE(PG8_SB(1, 0), cB + kstep, voffB); PG8_STAGE(PG8_SA(1, 0), cA + kstep, voffA); PG8_STAGE(PG8_SB(1, 1), cB + hstep + kstep, voffB);
        PG8_WAIT_V(6); PG8_BAR;
    }
    for (;;) {
        const bool has_next = S.next(ui + 1, nxt);
        const char* nA = has_next ? (const char*)g.A + (size_t)nxt.pm * tstep : cA; const char* nB = has_next ? (const char*)g.Bt + (size_t)nxt.pn * tstep : cB;
        for (int t = 0; t < nt; t += 2) {
            const bool last = (t == nt - 2);
            const char* a1 = cA + (size_t)(t + 1) * kstep;
            const char* a2 = last ? nA : cA + (size_t)(t + 2) * kstep; const char* b2 = last ? nB : cB + (size_t)(t + 2) * kstep;
            const char* a3 = a2 + kstep; const char* b3 = b2 + kstep;
            if (last && has_next) S.a_ready(nxt);
            if constexpr (SP2) {
            PG8_LDB(B0, 0, 0); PG8_LDB(B1, 0, 1); PG8_SCHED; PG8_LDA(At, 0, 0); PG8_STAGE(PG8_SA(1, 1), a1 + hstep, voffA);
            PG8_WAIT_V(8); PG8_WAIT_L(0); PG8_BAR; PG8_MMA(0, 0, At, B0); PG8_MMA(0, 1, At, B1); PG8_BAR; PG8_SCHED;
            PG8_LDA(At, 0, 1); PG8_STAGE(PG8_SB(0, 0), b2, voffB); PG8_STAGE(PG8_SB(0, 1), b2 + hstep, voffB); PG8_STAGE(PG8_SA(0, 0), a2, voffA);
            PG8_WAIT_V(8); PG8_WAIT_L(0); PG8_BAR; PG8_MMA(1, 0, At, B0); PG8_MMA(1, 1, At, B1); PG8_BAR; PG8_SCHED;
            PG8_LDB(B0, 1, 0); PG8_LDB(B1, 1, 1); PG8_SCHED; PG8_LDA(At, 1, 0); PG8_STAGE(PG8_SA(0, 1), a2 + hstep, voffA);
            PG8_WAIT_V(8); PG8_WAIT_L(0); PG8_BAR; PG8_MMA(0, 0, At, B0); PG8_MMA(0, 1, At, B1); PG8_BAR; PG8_SCHED;
            PG8_LDA(At, 1, 1); PG8_STAGE(PG8_SB(1, 0), b3, voffB); PG8_STAGE(PG8_SB(1, 1), b3 + hstep, voffB); PG8_STAGE(PG8_SA(1, 0), a3, voffA);
            PG8_WAIT_V(8); PG8_WAIT_L(0); PG8_BAR; PG8_MMA(1, 0, At, B0); PG8_MMA(1, 1, At, B1); PG8_BAR; PG8_SCHED;
            } else {
            PG8_LDB(B0, 0, 0); PG8_SCHED; PG8_LDA(At, 0, 0); PG8_STAGE(PG8_SA(1, 1), a1 + hstep, voffA);
            PG8_WAIT_L(8); PG8_BAR; PG8_WAIT_L(0); PG8_MMA(0, 0, At, B0); PG8_BAR; PG8_SCHED;
            PG8_LDB(B1, 0, 1); PG8_STAGE(PG8_SB(0, 0), b2, voffB);
            PG8_BAR; PG8_WAIT_L(0); PG8_MMA(0, 1, At, B1); PG8_BAR;
            PG8_LDA(At, 0, 1); PG8_STAGE(PG8_SA(0, 0), a2, voffA);
            PG8_BAR; PG8_WAIT_L(0); PG8_MMA(1, 0, At, B0); PG8_BAR; PG8_SCHED;
            PG8_STAGE(PG8_SB(0, 1), b2 + hstep, voffB);
            PG8_WAIT_V(6); PG8_BAR; PG8_MMA(1, 1, At, B1); PG8_BAR;
            PG8_LDB(B0, 1, 0); PG8_SCHED; PG8_LDA(At, 1, 0); PG8_STAGE(PG8_SA(0, 1), a2 + hstep, voffA);
            PG8_WAIT_L(8); PG8_BAR; PG8_WAIT_L(0); PG8_MMA(0, 0, At, B0); PG8_BAR; PG8_SCHED;
            PG8_LDB(B1, 1, 1); PG8_STAGE(PG8_SB(1, 0), b3, voffB);
            PG8_BAR; PG8_WAIT_L(0); PG8_MMA(0, 1, At, B1); PG8_BAR;
            PG8_LDA(At, 1, 1); PG8_STAGE(PG8_SA(1, 0), a3, voffA);
            PG8_BAR; PG8_WAIT_L(0); PG8_MMA(1, 0, At, B0); PG8_BAR; PG8_SCHED;
            PG8_STAGE(PG8_SB(1, 1), b3 + hstep, voffB);
            PG8_WAIT_V(6); PG8_BAR; PG8_MMA(1, 1, At, B1); PG8_BAR;
            }
        }
        if constexpr (ALIGN_EPI) { if (wr == 0) PG8_BAR; }
        if constexpr (!Epi::AFTER_DRAIN) { E(acc, cur, wr, wc, fr, fq); S.done(cur); }
        if (!has_next) break;
#pragma unroll
        for (int a = 0; a < 2; ++a)
#pragma unroll
            for (int b = 0; b < 2; ++b)
#pragma unroll
                for (int m = 0; m < 4; ++m)
#pragma unroll
                    for (int n = 0; n < 2; ++n) acc[a][b][m][n] = (f32x4){0.f, 0.f, 0.f, 0.f};
        cur = nxt; cA = nA; cB = nB; ++ui;
        if constexpr (ALIGN_EPI) { if (wr == 1) PG8_BAR; }
    }
    PG8_WAIT_V(0);
    if constexpr (!ALIGN_EPI) { if (wr == 0) PG8_BAR; }
    PG8_BAR;
    if constexpr (Epi::AFTER_DRAIN) { E.fused(acc, cur, wr, wc, fr, fq, lds, wid, lane); S.done(cur); }
#undef PG8_SA
#undef PG8_SB
#undef PG8_STAGE
#undef PG8_LDA
#undef PG8_LDB
#undef PG8_MMA
#undef PG8_WAIT_V
#undef PG8_WAIT_L
#undef PG8_BAR
#undef PG8_SCHED
}
}

constexpr int NWAVES = 8;
constexpr int BATCH = 4, SEQ = 8192, D = 1024, M = BATCH * SEQ;
constexpr int NH = 8, HD = 64, WA = 512, NIH = 8, IDD = 32, TOPK = 256, WB = 512, NG = 8, GD = 64, CHUNK = 128;
constexpr int INW = 1960, INWP = 2048, FF = 4096, CW = 31;
constexpr float EPS = 1e-6f;
#ifndef MK_ONE_LAUNCH
#define MK_ONE_LAUNCH 1
#endif
constexpr int N_PHASES = 11;

constexpr size_t MiB = 1u << 20;
constexpr size_t WS_CTL = 0, CTL_ZERO_BYTES = 1 * MiB;
constexpr size_t WS_WIN = 1 * MiB;
constexpr size_t WS_WOUT = 5 * MiB;
constexpr size_t WS_W1 = 7 * MiB;
constexpr size_t WS_W2 = 23 * MiB;
constexpr size_t WS_WPW1 = 39 * MiB;
constexpr size_t WS_WPW2 = 43 * MiB;
constexpr size_t WS_SSQ = 45 * MiB;
constexpr size_t WS_COS64 = 47 * MiB, WS_SIN64 = 51 * MiB;
constexpr size_t WS_COS32 = 55 * MiB, WS_SIN32 = 57 * MiB;
constexpr size_t WS_XB = 59 * MiB;
constexpr size_t WS_BIG = 123 * MiB;
constexpr size_t WS_Q = WS_BIG;
constexpr size_t WS_QI = WS_BIG + 32 * MiB;
constexpr size_t WS_U = WS_BIG + 64 * MiB;
constexpr size_t WS_VBG = WS_BIG + 96 * MiB;
constexpr size_t WS_MIX = WS_BIG + 128 * MiB;
constexpr size_t WS_KB = WS_BIG + 192 * MiB;
constexpr size_t WS_VB = WS_BIG + 196 * MiB;
constexpr size_t WS_KI = WS_BIG + 200 * MiB;
constexpr size_t WS_WI = WS_BIG + 204 * MiB;
constexpr size_t WS_SSQV = WS_BIG + 205 * MiB;
constexpr size_t WS_Y = WS_BIG;
constexpr size_t WS_YC = WS_BIG + 64 * MiB;
constexpr size_t WS_HID1 = WS_BIG;
constexpr size_t WS_END = WS_BIG + 256 * MiB;
constexpr int CW_BAR = 4096;

constexpr int RING_OFF = 0, RING_BYTES = 131072;
constexpr int LDSCTL_OFF = RING_BYTES, MISC_OFF = LDSCTL_OFF + 320;
constexpr int LDS_BYTES = 147456;

#define GAS __attribute__((address_space(1)))
#define LAS __attribute__((address_space(3)))
typedef unsigned short bf16;
typedef unsigned v4u __attribute__((ext_vector_type(4)));
typedef unsigned v2u __attribute__((ext_vector_type(2)));
typedef float f32x4 __attribute__((ext_vector_type(4)));
typedef GAS unsigned gu32;
#define RLX_AGENT __ATOMIC_RELAXED, __HIP_MEMORY_SCOPE_AGENT
#define LDS_WAIT() asm volatile("s_waitcnt lgkmcnt(0)" ::: "memory")
#define VM_WAIT() asm volatile("s_waitcnt vmcnt(0)" ::: "memory")
__device__ __forceinline__ unsigned f2bf(float f) { unsigned u = __builtin_bit_cast(unsigned, f); return (u + 0x7fffu + ((u >> 16) & 1u)) >> 16; }
__device__ __forceinline__ unsigned pk2(float lo, float hi) { return f2bf(lo) | (f2bf(hi) << 16); }
__device__ __forceinline__ float bf2f(unsigned short h) { return __builtin_bit_cast(float, (unsigned)h << 16); }
__device__ __forceinline__ float bflo(unsigned w) { return __builtin_bit_cast(float, w << 16); }
__device__ __forceinline__ float bfhi(unsigned w) { return __builtin_bit_cast(float, w & 0xffff0000u); }
#define XB_TMO      128
#define XB_XCNT(j)  (256  + 64 * (j))
#define XB_XSUB(j)  (1280 + 64 * (j))
#define XB_XGEN(j)  (2304 + 64 * (j))
#define XB_TOP      3328
#define XB_TOPGEN   3392
#define XCD_BAR_WORDS 3456
#define XB_SPIN_CAP (1u << 18)

__device__ __forceinline__ unsigned xb_ld(unsigned* p)              { return __hip_atomic_load(p, __ATOMIC_RELAXED, __HIP_MEMORY_SCOPE_AGENT); }
__device__ __forceinline__ unsigned xb_add(unsigned* p, unsigned v) { return __hip_atomic_fetch_add(p, v, __ATOMIC_RELAXED, __HIP_MEMORY_SCOPE_AGENT); }
__device__ __forceinline__ unsigned xb_xcc_id() { return (unsigned)__builtin_amdgcn_s_getreg((3 << 11) | 20) & 0xFu; }
#define XB_SPIN(cond, bar) do { unsigned _sp = 0; while (cond) { __builtin_amdgcn_s_sleep(1); \
    if ((++_sp & 255u) == 0u) { if (xb_ld(&(bar)[XB_TMO])) break; if (_sp > XB_SPIN_CAP) { atomicAdd(&(bar)[XB_TMO], 1u); break; } } } } while (0)

struct XcdBarrier {
    unsigned* bar; unsigned x;
    volatile LAS unsigned* st;
};

__device__ __forceinline__ XcdBarrier xcd_barrier_post(unsigned* bar, volatile LAS unsigned* st) {
    XcdBarrier b; b.bar = bar; b.x = xb_xcc_id(); b.st = st;
    if (threadIdx.x == 0) (void)xb_add(&bar[XB_XCNT(b.x)], 1u);
    return b;
}
__device__ __forceinline__ void xcd_barrier_complete(unsigned* bar, unsigned x, unsigned& nloc, unsigned& nx) {
    const unsigned G = gridDim.x * gridDim.y * gridDim.z;
    unsigned sum, cnt, mine, sp = 0u;
    for (;;) {
        sum = 0u; cnt = 0u; mine = 0u;
#pragma unroll
        for (unsigned j = 0; j < 16; ++j) { const unsigned c = xb_ld(&bar[XB_XCNT(j)]); sum += c; cnt += (c > 0u) ? 1u : 0u; mine = (j == x) ? c : mine; }
        if (sum == G) break;
        __builtin_amdgcn_s_sleep(1);
        if ((++sp & 255u) == 0u) { if (xb_ld(&bar[XB_TMO])) break; if (sp > XB_SPIN_CAP) { atomicAdd(&bar[XB_TMO], 1u); break; } }
    }
    nloc = mine > 0u ? mine : 1u; nx = cnt > 0u ? cnt : 1u;
}

__device__ __forceinline__ void xcd_barrier(const XcdBarrier& b) {
    asm volatile("s_waitcnt vmcnt(0)" ::: "memory");
    __syncthreads();
    if (threadIdx.x == 0) {
        unsigned* bar = b.bar;
        __builtin_amdgcn_s_waitcnt(0);
        unsigned nloc = b.st[0], nx = b.st[1];
        if (nloc == 0u) { xcd_barrier_complete(bar, b.x, nloc, nx); b.st[0] = nloc; b.st[1] = nx; }
        const unsigned old = xb_add(&bar[XB_XSUB(b.x)], 1u);
        const unsigned gen = old / nloc;
        if (old + 1u == (gen + 1u) * nloc) {
            __builtin_amdgcn_fence(__ATOMIC_RELEASE, "agent");
            asm volatile("s_waitcnt vmcnt(0)" ::: "memory");
            const unsigned og = xb_add(&bar[XB_TOP], 1u);
            const unsigned tg = og / nx;
            if (og + 1u == (tg + 1u) * nx) xb_add(&bar[XB_TOPGEN], 1u);
            else XB_SPIN(xb_ld(&bar[XB_TOPGEN]) == tg, bar);
            __builtin_amdgcn_fence(__ATOMIC_ACQUIRE, "agent");
            xb_add(&bar[XB_XGEN(b.x)], 1u);
            asm volatile("s_waitcnt vmcnt(0)" ::: "memory");
        } else {
            XB_SPIN(xb_ld(&bar[XB_XGEN(b.x)]) == gen, bar);
            __builtin_amdgcn_fence(__ATOMIC_ACQUIRE, "agent");
            asm volatile("s_waitcnt vmcnt(0)" ::: "memory");
        }
    }
    __syncthreads();
}

struct Args {
    const float* x; const int* pos; const float* ev_g_norm; const float* ev_w_in; const float* ev_g_q; const float* ev_g_k; const float* ev_g_kidx; const float* ev_g_vb;
    const float* ev_w_s; const float* ev_b_s; const float* ev_w_out; const float* od_g_norm; const float* od_w_pw1; const float* od_w_dw; const float* od_b_dw; const float* od_g_conv;
    const float* od_w_pw2; const float* ff_g_norm; const float* ff_w1; const float* ff_w2;
    float* out; unsigned char* ws;
    float invf64[32]; float invf32[16];
    int ph_lo, ph_hi;
};
struct Frame {
    LAS unsigned char* lds;
    volatile LAS unsigned* MISC;
    gu32* ctl;
    int tid, lane, wave;
    int vcu, G;
};

__device__ __forceinline__ float wave_sum(float v) {
#pragma unroll
    for (int o = 1; o < 64; o <<= 1) v += __shfl_xor(v, o);
    return v;
}
__device__ __forceinline__ float wave_max(float v) {
#pragma unroll
    for (int o = 1; o < 64; o <<= 1) v = fmaxf(v, __shfl_xor(v, o));
    return v;
}

__host__ __device__ __forceinline__ int in_src_col(int np) {
    const int pn = np >> 8, c = np & 255, bj = c >> 7, wc = (c >> 5) & 3, j = c & 31;
    if (pn < 2) return 64 * (4 * pn + wc) + 32 * bj + j;
    if (pn == 2) {
        if (wc == 0) return 512 + 32 * bj + j;
        if (wc == 1) return 576 + 32 * bj + j;
        if (wc == 2) { if (j < 16) return 896 + 16 * bj + j; if (bj == 0 && j < 24) return 928 + (j - 16); return -1; }
        return -1;
    }
    if (pn == 3) return 640 + 32 * (2 * wc + (j >> 4)) + 16 * bj + (j & 15);
    if (pn < 6) return 936 + 256 * (pn - 4) + c;
    return 1448 + 256 * (pn - 6) + c;
}
__host__ __device__ __forceinline__ int glu_src_col(int np) { const int pn = np >> 8, c = np & 255; return (c >> 7) * 1024 + 128 * pn + (c & 127); }

__device__ __forceinline__ void p0_transpose_item(const float* W, int K, int N, int NP, const float* gk, int mode, bf16* WT, LAS float* scr, int item, int lane) {
    const int nblk = NP / 32, kb = item / nblk, nb = item % nblk, k0 = 64 * kb, n0 = 32 * nb;
    const int np = n0 + (lane & 31);
    const int sc = mode == 0 ? np : (mode == 1 ? in_src_col(np) : glu_src_col(np));
#pragma unroll 8
    for (int i = 0; i < 32; ++i) { const int kk = 2 * i + (lane >> 5); float v = sc >= 0 ? W[(size_t)(k0 + kk) * N + sc] : 0.f; if (gk) v *= gk[k0 + kk]; scr[kk * 33 + (lane & 31)] = v; }
    LDS_WAIT(); asm volatile("" ::: "memory");
    const int c = lane & 7;
#pragma unroll
    for (int j = 0; j < 4; ++j) { const int n = (lane >> 3) + 8 * j; const LAS float* s = scr + (8 * c) * 33 + n;
        v4u o; o.x = pk2(s[0 * 33], s[1 * 33]); o.y = pk2(s[2 * 33], s[3 * 33]); o.z = pk2(s[4 * 33], s[5 * 33]); o.w = pk2(s[6 * 33], s[7 * 33]);
        *(GAS v4u*)(WT + (size_t)(n0 + n) * K + k0 + 8 * c) = o; }
    LDS_WAIT(); asm volatile("" ::: "memory");
}

__device__ __forceinline__ void sincos_acc(float ang, float& s, float& c) {
    const double a = (double)ang;
    const double q = __builtin_rint(a * 0.63661977236758134308);
    double r = __builtin_fma(-q, 1.57079632679489655800e+00, a);
    r = __builtin_fma(-q, 6.12323399573676603587e-17, r);
    const double r2 = r * r;
    double sp = 1.0 / 6227020800.0; sp = sp * r2 - 1.0 / 39916800.0; sp = sp * r2 + 1.0 / 362880.0; sp = sp * r2 - 1.0 / 5040.0; sp = sp * r2 + 1.0 / 120.0; sp = sp * r2 - 1.0 / 6.0; sp = sp * r2 * r + r;
    double cp = 1.0 / 479001600.0; cp = cp * r2 - 1.0 / 3628800.0; cp = cp * r2 + 1.0 / 40320.0; cp = cp * r2 - 1.0 / 720.0; cp = cp * r2 + 1.0 / 24.0; cp = cp * r2 - 0.5; cp = cp * r2 + 1.0;
    const int qi = (int)(long long)q & 3;
    const double ss = (qi & 1) ? cp : sp, cc = (qi & 1) ? sp : cp;
    s = (float)((qi & 2) ? -ss : ss);
    c = (float)(((qi + 1) & 2) ? -cc : cc);
}

__device__ __forceinline__ void p0_prologue(Frame& F, const Args& A) {
    unsigned char* ws = A.ws;
    LAS float* scr = (LAS float*)(F.lds + RING_OFF + F.wave * 16384);
    const int gw = F.vcu * NWAVES + F.wave, NGW = F.G * NWAVES;
    constexpr int I_IN = (D / 64) * (INWP / 32), I_OUT = (D / 64) * (D / 32), I_1 = (D / 64) * (FF / 32), I_2 = (FF / 64) * (D / 32), I_P1 = (D / 64) * (2 * D / 32), I_P2 = I_OUT;
    constexpr int NITEMS = I_IN + I_OUT + 2 * I_1 + 2 * I_2 + I_P1 + I_P2;
    for (int it = gw; it < NITEMS; it += NGW) {
        int r = it;
        if (r < I_IN) { p0_transpose_item(A.ev_w_in, D, INW, INWP, A.ev_g_norm, 1, (bf16*)(ws + WS_WIN), scr, r, F.lane); continue; } r -= I_IN;
        if (r < I_OUT) { p0_transpose_item(A.ev_w_out, D, D, D, nullptr, 0, (bf16*)(ws + WS_WOUT), scr, r, F.lane); continue; } r -= I_OUT;
        if (r < 2 * I_1) { const int l = r / I_1; p0_transpose_item(A.ff_w1 + (size_t)l * D * FF, D, FF, FF, A.ff_g_norm + l * D, 0, (bf16*)(ws + WS_W1) + (size_t)l * D * FF, scr, r % I_1, F.lane); continue; } r -= 2 * I_1;
        if (r < 2 * I_2) { const int l = r / I_2; p0_transpose_item(A.ff_w2 + (size_t)l * D * FF, FF, D, D, nullptr, 0, (bf16*)(ws + WS_W2) + (size_t)l * D * FF, scr, r % I_2, F.lane); continue; } r -= 2 * I_2;
        if (r < I_P1) { p0_transpose_item(A.od_w_pw1, D, 2 * D, 2 * D, A.od_g_norm, 2, (bf16*)(ws + WS_WPW1), scr, r, F.lane); continue; } r -= I_P1;
        p0_transpose_item(A.od_w_pw2, D, D, D, nullptr, 0, (bf16*)(ws + WS_WPW2), scr, r, F.lane);
    }
    bf16* XB = (bf16*)(ws + WS_XB); float* ssq = (float*)(ws + WS_SSQ);
    for (int m = gw; m < M; m += NGW) {
        const GAS f32x4* xr = (const GAS f32x4*)(A.x + (size_t)m * D) + F.lane;
        f32x4 v[4]; float s = 0.f;
#pragma unroll
        for (int j = 0; j < 4; ++j) { v[j] = xr[64 * j]; s += (v[j].x * v[j].x + v[j].y * v[j].y) + (v[j].z * v[j].z + v[j].w * v[j].w); }
        s = wave_sum(s);
        GAS unsigned long long* o8 = (GAS unsigned long long*)(XB + (size_t)m * D) + F.lane;
#pragma unroll
        for (int j = 0; j < 4; ++j) o8[64 * j] = (unsigned long long)pk2(v[j].x, v[j].y) | ((unsigned long long)pk2(v[j].z, v[j].w) << 32);
        if (F.lane < 16) ssq[(size_t)m * 16 + F.lane] = F.lane == 0 ? s : 0.f;
    }
    float* c64 = (float*)(ws + WS_COS64); float* s64 = (float*)(ws + WS_SIN64); float* c32 = (float*)(ws + WS_COS32); float* s32 = (float*)(ws + WS_SIN32);
    const int gt = F.vcu * (NWAVES * 64) + F.tid, NGT = F.G * NWAVES * 64;
    for (int e = gt; e < M * 32; e += NGT) { const int tok = e >> 5, i = e & 31; const float ang = (float)A.pos[tok] * A.invf64[i]; float s, c; sincos_acc(ang, s, c); c64[e] = c; s64[e] = s; }
    for (int e = gt; e < M * 16; e += NGT) { const int tok = e >> 4, i = e & 15; const float ang = (float)A.pos[tok] * A.invf32[i]; float s, c; sincos_acc(ang, s, c); c32[e] = c; s32[e] = s; }
}

__device__ __forceinline__ unsigned f2key(float f) { const unsigned u = __builtin_bit_cast(unsigned, f); return (u & 0x80000000u) ? ~u : (u | 0x80000000u); }

__device__ __forceinline__ void attn_simple_phase(Frame& F, const Args& A) {
    unsigned char* ws = A.ws;
    const bf16* Qg = (const bf16*)(ws + WS_Q); const bf16* Kb = (const bf16*)(ws + WS_KB); const bf16* Vb = (const bf16*)(ws + WS_VB);
    const float* Qi = (const float*)(ws + WS_QI); const float* Ki = (const float*)(ws + WS_KI); const float* Wi = (const float*)(ws + WS_WI);
    bf16* MIX = (bf16*)(ws + WS_MIX);
    LAS unsigned* keyL = (LAS unsigned*)(F.lds);
    LAS float* qiL = (LAS float*)(F.lds + 32768);
    LAS float* qL = (LAS float*)(F.lds + 32768 + 1024);
    LAS float* wiL = (LAS float*)(F.lds + 32768 + 3072);
    LAS unsigned* hist = (LAS unsigned*)(F.lds + 32768 + 4096);
    LAS int* sel = (LAS int*)(F.lds + 32768 + 5120);
    LAS float* lg = (LAS float*)(F.lds + 32768 + 6144);
    LAS unsigned* wtot = (LAS unsigned*)(F.lds + 32768 + 6144 + 8192);
    LAS unsigned* bc = (LAS unsigned*)(F.lds + 32768 + 6144 + 8192 + 64);
    const int tid = F.tid, lane = F.lane, wave = F.wave;
    for (int tok = F.vcu; tok < M; tok += F.G) {
        const int b = tok / SEQ, t = tok % SEQ, n = t + 1;
        const size_t kb0 = (size_t)b * SEQ;
        __syncthreads();
        if (tid < 256) qiL[tid] = Qi[(size_t)tok * 256 + tid];
        qL[tid] = bf2f(Qg[(size_t)tok * 512 + tid]);
        if (tid < 8) wiL[tid] = Wi[(size_t)tok * 8 + tid];
        __syncthreads();
        int nsel;
        if (n > TOPK) {
            for (int s = tid; s < n; s += NWAVES * 64) {
                asm volatile("" ::: "memory");
                const f32x4* kp = (const f32x4*)(Ki + (kb0 + s) * 32);
                f32x4 kv[8];
#pragma unroll
                for (int j = 0; j < 8; ++j) kv[j] = kp[j];
                float sc = 0.f;
#pragma unroll
                for (int h = 0; h < 8; ++h) {
                    float d = 0.f;
#pragma unroll
                    for (int j = 0; j < 8; ++j) { const f32x4 qv = *(const LAS f32x4*)(qiL + h * 32 + 4 * j); d += kv[j].x * qv.x; d += kv[j].y * qv.y; d += kv[j].z * qv.z; d += kv[j].w * qv.w; }
                    sc += wiL[h] * fmaxf(d, 0.f);
                }
                keyL[s] = f2key(sc);
            }
            unsigned prefix = 0u, mask = 0u, need = TOPK;
            for (int shift = 24; shift >= 0; shift -= 8) {
                if (tid < 256) hist[tid] = 0u;
                __syncthreads();
                for (int s = tid; s < n; s += NWAVES * 64) { const unsigned u = keyL[s]; if ((u & mask) == prefix) __hip_atomic_fetch_add(&hist[(u >> shift) & 255u], 1u, __ATOMIC_RELAXED, __HIP_MEMORY_SCOPE_WORKGROUP); }
                __syncthreads();
                if (wave == 0) {
                    const unsigned h0 = hist[4 * lane], h1 = hist[4 * lane + 1], h2 = hist[4 * lane + 2], h3 = hist[4 * lane + 3];
                    const unsigned c = h0 + h1 + h2 + h3;
                    unsigned sfx = c;
#pragma unroll
                    for (int o = 1; o < 64; o <<= 1) { const unsigned v = __shfl_down(sfx, o); if (lane + o < 64) sfx += v; }
                    const unsigned above = sfx - c;
                    if (above < need && sfx >= need) {
                        unsigned rem = need - above, dsel, cab;
                        if (h3 >= rem) { dsel = 3; cab = 0; } else if (h3 + h2 >= rem) { dsel = 2; cab = h3; } else if (h3 + h2 + h1 >= rem) { dsel = 1; cab = h3 + h2; } else { dsel = 0; cab = h3 + h2 + h1; }
                        bc[0] = 4 * lane + dsel; bc[1] = rem - cab;
                    }
                }
                __syncthreads();
                const unsigned dsel = bc[0]; need = bc[1];
                prefix |= dsel << shift; mask |= 255u << shift;
                __syncthreads();
            }
            const unsigned T = prefix, cgt = TOPK - need;
            unsigned run = 0u;
            for (int base = 0; base < n; base += NWAVES * 64) {
                const int s = base + tid; const unsigned u = s < n ? keyL[s] : 0u;
                const bool gt = s < n && u > T, eq = s < n && u == T;
                const unsigned long long bg = __ballot(gt), be = __ballot(eq);
                const unsigned long long lt = (1ull << lane) - 1ull;
                const unsigned pg = __popcll(bg & lt), pe = __popcll(be & lt);
                if (lane == 0) wtot[wave] = (unsigned)__popcll(bg) | ((unsigned)__popcll(be) << 16);
                __syncthreads();
                unsigned off = run, tot = 0u;
#pragma unroll
                for (int w = 0; w < NWAVES; ++w) { const unsigned v = wtot[w]; if (w < wave) off += v; tot += v; }
                if (gt) sel[(off & 0xffffu) + pg] = s;
                if (eq) { const unsigned rk = (off >> 16) + pe; if (rk < need) sel[cgt + rk] = s; }
                run += tot;
                __syncthreads();
            }
            nsel = TOPK;
        } else {
            if (tid < n) sel[tid] = tid;
            nsel = n;
        }
        __syncthreads();
        {
            const int j = tid & 255, hh = tid >> 8;
            float l0 = -INFINITY, l1 = -INFINITY, l2 = -INFINITY, l3 = -INFINITY;
            if (j < nsel) {
                const v4u* kp = (const v4u*)(Kb + (kb0 + sel[j]) * 64);
                l0 = l1 = l2 = l3 = 0.f;
#pragma unroll 1
                for (int c = 0; c < 8; ++c) {
                    asm volatile("" ::: "memory");
                    const v4u kw = kp[c];
                    const float k0 = bflo(kw.x), k1 = bfhi(kw.x), k2 = bflo(kw.y), k3 = bfhi(kw.y), k4 = bflo(kw.z), k5 = bfhi(kw.z), k6 = bflo(kw.w), k7 = bfhi(kw.w);
#pragma unroll
                    for (int h = 0; h < 4; ++h) {
                        const LAS float* qp = qL + (4 * hh + h) * 64 + 8 * c;
                        const f32x4 qa = *(const LAS f32x4*)qp, qb = *(const LAS f32x4*)(qp + 4);
                        const float d = (k0 * qa.x + k1 * qa.y) + (k2 * qa.z + k3 * qa.w) + (k4 * qb.x + k5 * qb.y) + (k6 * qb.z + k7 * qb.w);
                        if (h == 0) l0 += d; else if (h == 1) l1 += d; else if (h == 2) l2 += d; else l3 += d;
                    }
                }
            }
            lg[(4 * hh + 0) * 256 + j] = l0; lg[(4 * hh + 1) * 256 + j] = l1; lg[(4 * hh + 2) * 256 + j] = l2; lg[(4 * hh + 3) * 256 + j] = l3;
        }
        __syncthreads();
        {
            float v[4]; float mx = -INFINITY;
#pragma unroll
            for (int i = 0; i < 4; ++i) { v[i] = lg[wave * 256 + lane + 64 * i]; mx = fmaxf(mx, v[i]); }
            mx = wave_max(mx); float sm = 0.f;
#pragma unroll
            for (int i = 0; i < 4; ++i) { v[i] = __expf(v[i] - mx); sm += v[i]; }
            sm = wave_sum(sm); const float inv = 1.0f / sm;
#pragma unroll
            for (int i = 0; i < 4; ++i) lg[wave * 256 + lane + 64 * i] = v[i] * inv;
        }
        __syncthreads();
        {
            float o = 0.f;
#pragma unroll 4
            for (int j = 0; j < nsel; ++j) o += lg[wave * 256 + j] * bf2f(Vb[(kb0 + sel[j]) * 64 + lane]);
            MIX[(size_t)tok * 1024 + wave * 64 + lane] = (bf16)f2bf(o);
        }
    }
    __syncthreads();
}

__device__ __forceinline__ void gating_simple_phase(Frame& F, const Args& A) {
    unsigned char* ws = A.ws;
    const bf16* U = (const bf16*)(ws + WS_U); const bf16* VBg = (const bf16*)(ws + WS_VBG); const float* ssqv = (const float*)(ws + WS_SSQV);
    bf16* MIX = (bf16*)(ws + WS_MIX);
    LAS float* vv = (LAS float*)F.lds;
    const int tid = F.tid, lane = F.lane, wave = F.wave;
    for (int unit = F.vcu; unit < (M / CHUNK) * NG; unit += F.G) {
        const int c = unit >> 3, g = unit & 7; const size_t tok0 = (size_t)c * CHUNK;
        __syncthreads();
        for (int e = tid; e < CHUNK * GD; e += NWAVES * 64) {
            const int j = e >> 6, d = e & 63; const size_t tok = tok0 + j;
            const f32x4 a = *(const f32x4*)(ssqv + tok * 8), b2 = *(const f32x4*)(ssqv + tok * 8 + 4);
            const float ri = __builtin_amdgcn_rsqf((((a.x + a.y) + (a.z + a.w)) + ((b2.x + b2.y) + (b2.z + b2.w))) * (1.0f / 512.0f) + EPS);
            vv[e] = bf2f(VBg[tok * 512 + g * 64 + d]) * ri * A.ev_g_vb[g * 64 + d];
        }
        __syncthreads();
        const float* Wg = A.ev_w_s + (size_t)g * CHUNK * CHUNK;
        for (int r = 0; r < 16; ++r) {
            const int i = wave + 8 * r;
            const float* wrow = Wg + (size_t)i * CHUNK;
            float acc = 0.f;
            for (int j = 0; j <= i; ++j) acc += wrow[j] * vv[j * 64 + lane];
            const size_t tok = tok0 + i;
            const float sv = acc + A.ev_b_s[g * CHUNK + i];
            MIX[tok * 1024 + 512 + g * 64 + lane] = (bf16)f2bf(bf2f(U[tok * 512 + g * 64 + lane]) * sv);
        }
    }
    __syncthreads();
}

__device__ __forceinline__ void conv_simple_phase(Frame& F, const Args& A) {
    unsigned char* ws = A.ws;
    const bf16* Y = (const bf16*)(ws + WS_Y); bf16* YC = (bf16*)(ws + WS_YC);
    constexpr int TS = 16, ROWS = TS + CW - 1;
    LAS unsigned* yl = (LAS unsigned*)F.lds;
    LAS float* part = (LAS float*)(F.lds + ROWS * 2048);
    const int tid = F.tid, lane = F.lane, wave = F.wave;
    float w0[CW], w1[CW];
#pragma unroll
    for (int k = 0; k < CW; ++k) { w0[k] = A.od_w_dw[k * D + 2 * tid]; w1[k] = A.od_w_dw[k * D + 2 * tid + 1]; }
    const float b0 = A.od_b_dw[2 * tid], b1 = A.od_b_dw[2 * tid + 1], g0 = A.od_g_conv[2 * tid], g1 = A.od_g_conv[2 * tid + 1];
    for (int strip = F.vcu; strip < M / TS; strip += F.G) {
        const int tok0 = strip * TS, s0 = tok0 % SEQ;
        __syncthreads();
        for (int r = 0; r < ROWS; ++r) { const int s = s0 - (CW - 1) + r; yl[r * 512 + tid] = s >= 0 ? *(const unsigned*)(Y + (size_t)(tok0 - (CW - 1) + r) * D + 2 * tid) : 0u; }
        __syncthreads();
        float o0[TS], o1[TS];
#pragma unroll
        for (int tk = 0; tk < TS; ++tk) {
            float a0 = b0, a1 = b1;
#pragma unroll
            for (int k = 0; k < CW; ++k) { const unsigned w = yl[(tk + k) * 512 + tid]; a0 += w0[k] * bflo(w); a1 += w1[k] * bfhi(w); }
            o0[tk] = a0; o1[tk] = a1;
            const float ss = wave_sum(a0 * a0 + a1 * a1);
            if (lane == 0) part[tk * 8 + wave] = ss;
        }
        __syncthreads();
#pragma unroll
        for (int tk = 0; tk < TS; ++tk) {
            const f32x4 pa = *(const LAS f32x4*)(part + tk * 8), pb = *(const LAS f32x4*)(part + tk * 8 + 4);
            const float ri = __builtin_amdgcn_rsqf((((pa.x + pa.y) + (pa.z + pa.w)) + ((pb.x + pb.y) + (pb.z + pb.w))) * (1.0f / 1024.0f) + EPS);
            const float y0 = o0[tk] * ri * g0, y1 = o1[tk] * ri * g1;
            const float z0 = y0 * __builtin_amdgcn_rcpf(1.0f + __builtin_amdgcn_exp2f(y0 * -1.4426950408889634f)), z1 = y1 * __builtin_amdgcn_rcpf(1.0f + __builtin_amdgcn_exp2f(y1 * -1.4426950408889634f));
            *(unsigned*)(YC + (size_t)(tok0 + tk) * D + 2 * tid) = pk2(z0, z1);
        }
    }
    __syncthreads();
}

__global__ void __launch_bounds__(NWAVES * 64, 2) mk_fwd(Args args) {
    extern __shared__ __attribute__((aligned(16))) unsigned char lds[];
    Frame F;
    F.lds = (LAS unsigned char*)lds;
    F.MISC = (volatile LAS unsigned*)(F.lds + MISC_OFF);
    F.tid = threadIdx.x; F.lane = F.tid & 63; F.wave = __builtin_amdgcn_readfirstlane(F.tid >> 6);
    F.G = gridDim.x; { const int bx = blockIdx.x; F.vcu = (F.G % 8 == 0) ? (bx % 8) * (F.G / 8) + bx / 8 : bx; }
    unsigned char* ws = args.ws;
    F.ctl = (gu32*)(ws + WS_CTL);
    for (int u = F.tid; u < (LDS_BYTES - LDSCTL_OFF) / 4; u += NWAVES * 64) ((LAS unsigned*)(F.lds + LDSCTL_OFF))[u] = 0u;
    __syncthreads();
#if MK_ONE_LAUNCH
    XcdBarrier bar = xcd_barrier_post((unsigned*)(F.ctl + CW_BAR), F.MISC + 8);
#define GRID_BAR() xcd_barrier(bar)
#else
#define GRID_BAR() do {} while (0)
#endif
    const int lo = args.ph_lo, hi = args.ph_hi;
#ifndef PH_MASK
#define PH_MASK 0x7ff
#endif
#define IN(k) (((PH_MASK >> (k)) & 1) && lo <= (k) && (k) < hi)
#define SEAM(k) do { if (IN(k) && IN((k) + 1)) GRID_BAR(); __builtin_amdgcn_sched_barrier(0); asm volatile("" ::: "memory"); } while (0)
    using pg8::bf16_t;
    bf16_t* XB = (bf16_t*)(ws + WS_XB); float* SSQ = (float*)(ws + WS_SSQ);

    if (IN(0)) { p0_prologue(F, args); } SEAM(0);
    if (IN(1)) {
        pg8::Gemm g{XB, (const bf16_t*)(ws + WS_WIN), M, INWP, D}; pg8::StaticOrder S; S.init(M, INWP, F.G, (int)blockIdx.x);
        pg8::EpiIn E{SSQ, (const float*)(ws + WS_COS64), (const float*)(ws + WS_SIN64), (const float*)(ws + WS_COS32), (const float*)(ws + WS_SIN32), args.ev_g_q, args.ev_g_k, args.ev_g_kidx,
                     (bf16_t*)(ws + WS_Q), (bf16_t*)(ws + WS_KB), (bf16_t*)(ws + WS_VB), (float*)(ws + WS_QI), (float*)(ws + WS_KI), (float*)(ws + WS_WI), (bf16_t*)(ws + WS_U), (bf16_t*)(ws + WS_VBG), (float*)(ws + WS_SSQV)};
        pg8::gemm_phase<pg8::EpiIn, pg8::StaticOrder, true, true>(F.lds + RING_OFF, g, S, E);
    } SEAM(1);
    if (IN(2)) {
#ifndef NO_ATTN
        attn_simple_phase(F, args);
#endif
#ifndef NO_GATE
        gating_simple_phase(F, args);
#endif
    } SEAM(2);
    if (IN(3)) {
        pg8::Gemm g{(const bf16_t*)(ws + WS_MIX), (const bf16_t*)(ws + WS_WOUT), M, D, D}; pg8::StaticOrder S; S.init(M, D, F.G, (int)blockIdx.x);
        pg8::EpiRes E{args.x, args.out, XB, SSQ};
        pg8::gemm_phase<pg8::EpiRes, pg8::StaticOrder, true, true>(F.lds + RING_OFF, g, S, E);
    } SEAM(3);
    if (IN(4)) {
        pg8::Gemm g{XB, (const bf16_t*)(ws + WS_W1), M, FF, D}; pg8::StaticOrder S; S.init(M, FF, F.G, (int)blockIdx.x);
        pg8::EpiUp E{SSQ, (bf16_t*)(ws + WS_BIG), FF};
        pg8::gemm_phase<pg8::EpiUp, pg8::StaticOrder, true, true>(F.lds + RING_OFF, g, S, E);
    } SEAM(4);
    if (IN(5)) {
        pg8::Gemm g{(const bf16_t*)(ws + WS_BIG), (const bf16_t*)(ws + WS_W2), M, D, FF}; pg8::StaticOrder S; S.init(M, D, F.G, (int)blockIdx.x);
        pg8::EpiRes E{args.out, args.out, XB, SSQ};
        pg8::gemm_phase<pg8::EpiRes, pg8::StaticOrder, true, true>(F.lds + RING_OFF, g, S, E);
    } SEAM(5);
    if (IN(6)) {
        pg8::Gemm g{XB, (const bf16_t*)(ws + WS_WPW1), M, 2 * D, D}; pg8::StaticOrder S; S.init(M, 2 * D, F.G, (int)blockIdx.x);
        pg8::EpiGlu E{SSQ, (bf16_t*)(ws + WS_Y)};
        pg8::gemm_phase<pg8::EpiGlu, pg8::StaticOrder, true, true>(F.lds + RING_OFF, g, S, E);
    } SEAM(6);
    if (IN(7)) { conv_simple_phase(F, args); } SEAM(7);
    if (IN(8)) {
        pg8::Gemm g{(const bf16_t*)(ws + WS_YC), (const bf16_t*)(ws + WS_WPW2), M, D, D}; pg8::StaticOrder S; S.init(M, D, F.G, (int)blockIdx.x);
        pg8::EpiRes E{args.out, args.out, XB, SSQ};
        pg8::gemm_phase<pg8::EpiRes, pg8::StaticOrder, true, true>(F.lds + RING_OFF, g, S, E);
    } SEAM(8);
    if (IN(9)) {
        pg8::Gemm g{XB, (const bf16_t*)(ws + WS_W1) + (size_t)D * FF, M, FF, D}; pg8::StaticOrder S; S.init(M, FF, F.G, (int)blockIdx.x);
        pg8::EpiUp E{SSQ, (bf16_t*)(ws + WS_HID1), FF};
        pg8::gemm_phase<pg8::EpiUp, pg8::StaticOrder, true, true>(F.lds + RING_OFF, g, S, E);
    } SEAM(9);
    if (IN(10)) {
        pg8::Gemm g{(const bf16_t*)(ws + WS_HID1), (const bf16_t*)(ws + WS_W2) + (size_t)D * FF, M, D, FF}; pg8::StaticOrder S; S.init(M, D, F.G, (int)blockIdx.x);
        pg8::EpiRes E{args.out, args.out, nullptr, nullptr};
        pg8::gemm_phase<pg8::EpiRes, pg8::StaticOrder, true, true>(F.lds + RING_OFF, g, S, E);
    }
#undef IN
#undef SEAM
}

extern "C" void kernel_launch(void* const* d_in, const int* in_sizes, int n_in, void* d_out, int out_size, void* d_ws, size_t ws_size, hipStream_t stream) {
    static int grid = 0;
    if (grid == 0) {
        if (n_in != 20 || in_sizes[0] != M * D || out_size != M * D || ws_size < WS_END) { fprintf(stderr, "kernel_launch: unexpected problem shape (n_in %d, in0 %d, out %d, ws %zu < %zu); nothing launched\n", n_in, n_in > 0 ? in_sizes[0] : -1, out_size, ws_size, (size_t)WS_END); grid = -1; return; }
        int dev = 0, cus = 0, per_cu = 0;
        if (hipGetDevice(&dev) != hipSuccess || hipDeviceGetAttribute(&cus, hipDeviceAttributeMultiprocessorCount, dev) != hipSuccess) { grid = -1; return; }
        if (hipFuncSetAttribute((const void*)mk_fwd, hipFuncAttributeMaxDynamicSharedMemorySize, LDS_BYTES) != hipSuccess) { fprintf(stderr, "kernel_launch: hipFuncSetAttribute failed\n"); grid = -1; return; }
        if (hipOccupancyMaxActiveBlocksPerMultiprocessor(&per_cu, (const void*)mk_fwd, NWAVES * 64, LDS_BYTES) != hipSuccess || per_cu < 1) { fprintf(stderr, "kernel_launch: occupancy query says %d blocks per CU\n", per_cu); per_cu = 1; }
        (void)hipGetLastError();
        grid = cus;
    }
    if (grid < 0) return;
    (void)hipMemsetAsync((char*)d_ws + WS_CTL, 0, CTL_ZERO_BYTES, stream);
    Args a{};
    a.x = (const float*)d_in[0]; a.pos = (const int*)d_in[1]; a.ev_g_norm = (const float*)d_in[2]; a.ev_w_in = (const float*)d_in[3]; a.ev_g_q = (const float*)d_in[4]; a.ev_g_k = (const float*)d_in[5];
    a.ev_g_kidx = (const float*)d_in[6]; a.ev_g_vb = (const float*)d_in[7]; a.ev_w_s = (const float*)d_in[8]; a.ev_b_s = (const float*)d_in[9]; a.ev_w_out = (const float*)d_in[10];
    a.od_g_norm = (const float*)d_in[11]; a.od_w_pw1 = (const float*)d_in[12]; a.od_w_dw = (const float*)d_in[13]; a.od_b_dw = (const float*)d_in[14]; a.od_g_conv = (const float*)d_in[15]; a.od_w_pw2 = (const float*)d_in[16];
    a.ff_g_norm = (const float*)d_in[17]; a.ff_w1 = (const float*)d_in[18]; a.ff_w2 = (const float*)d_in[19];
    a.out = (float*)d_out; a.ws = (unsigned char*)d_ws;
    for (int i = 0; i < 32; ++i) a.invf64[i] = powf(10000.0f, -(float)i * 2.0f / 64.0f);
    for (int i = 0; i < 16; ++i) a.invf32[i] = powf(10000.0f, -(float)i * 2.0f / 32.0f);
#if MK_ONE_LAUNCH
    a.ph_lo = 0; a.ph_hi = N_PHASES;
    void* kargs[] = {&a};
    hipError_t e = hipLaunchCooperativeKernel((const void*)mk_fwd, dim3(grid), dim3(NWAVES * 64), kargs, LDS_BYTES, stream);
    if (e != hipSuccess) fprintf(stderr, "kernel_launch: cooperative launch failed: %s (grid %d)\n", hipGetErrorString(e), grid);
#else
    for (int p = 0; p < N_PHASES; ++p) {
        a.ph_lo = p; a.ph_hi = p + 1;
        hipLaunchKernelGGL(mk_fwd, dim3(grid), dim3(NWAVES * 64), LDS_BYTES, stream, a);
    }
#endif
}
```

```cpp
#include <hip/hip_runtime.h>
#include <cstdio>
#include <cstdint>
#include <cmath>
namespace pg8 {
#define PG8_LAS __attribute__((address_space(3)))
typedef unsigned short bf16_t;
typedef short bf16x8 __attribute__((ext_vector_type(8)));
typedef float f32x4 __attribute__((ext_vector_type(4)));
typedef unsigned u32x4 __attribute__((ext_vector_type(4)));
constexpr int BM = 256, BK = 64, HALF = 128, HTB = HALF * BK * 2  , STAGE_BYTES = 8 * HTB, NXCD = 8, WGM = 8;

__host__ __device__ __forceinline__ int lds_byte(int r, int c) { const int st = (r >> 4) * 2 + (c >> 5), rr = r & 15, cc = c & 31, ob = rr * 64 + cc * 2; return st * 1024 + (ob ^ (((ob >> 9) & 1) << 5)); }
__host__ __device__ __forceinline__ void stage_rc(int b, int& R, int& C) { const int st = b / 1024, sb = b % 1024, swz = sb ^ (((sb >> 9) & 1) << 5); R = (st >> 1) * 16 + swz / 64; C = (st & 1) * 32 + (swz % 64) / 2; }
__host__ __device__ __forceinline__ int perm32(int rho) { const int n = rho >> 4, i = rho & 15; return 8 * (i >> 2) + 4 * n + (i & 3); }

struct Unit { int pm, pn; };
struct Gemm { const bf16_t* A; const bf16_t* Bt; int M, N, K; };

struct StaticOrder {
    int nM, nN, nwg, G, c;
    __host__ __device__ void init(int M, int N, int G_, int c_) { nM = M / BM; nN = N / BM; nwg = nM * nN; G = G_; c = c_; }
    __host__ __device__ bool next(int i, Unit& u) const {
        const long L = (long)i * G + c; if (L >= nwg) return false;
        int wgid = (int)L; { const int q = nwg / NXCD, r = nwg % NXCD, xcd = wgid % NXCD, off = wgid / NXCD; wgid = (xcd < r ? xcd * (q + 1) : r * (q + 1) + (xcd - r) * q) + off; }
        const int nig = WGM * nN, gid = wgid / nig, fm = gid * WGM, gsz = (nM - fm) < WGM ? (nM - fm) : WGM;
        u.pm = fm + ((wgid % nig) % gsz); u.pn = (wgid % nig) / gsz; return true;
    }
    __device__ __forceinline__ void a_ready(const Unit&) const {}
    __device__ __forceinline__ void done(const Unit&) const {}
};

__device__ __forceinline__ unsigned cvt_pk_bf16(float lo, float hi) { unsigned r; asm volatile("v_cvt_pk_bf16_f32 %0, %1, %2" : "=v"(r) : "v"(lo), "v"(hi)); return r; }
typedef unsigned u32x2 __attribute__((ext_vector_type(2)));
constexpr float RMS_EPS = 1e-6f;
__device__ __forceinline__ float dot4(const f32x4 a) { return (a[0] * a[0] + a[1] * a[1]) + (a[2] * a[2] + a[3] * a[3]); }
__device__ __forceinline__ float row_rinv(const float* ssq, int row) {
    const f32x4* p = (const f32x4*)(ssq + (size_t)row * 16);
    const f32x4 a = p[0], b = p[1], c = p[2], d = p[3];
    const float s = ((a[0] + a[1]) + (a[2] + a[3])) + ((b[0] + b[1]) + (b[2] + b[3])) + ((c[0] + c[1]) + (c[2] + c[3])) + ((d[0] + d[1]) + (d[2] + d[3]));
    return __builtin_amdgcn_rsqf(s * (1.0f / 1024.0f) + RMS_EPS);
}
__device__ __forceinline__ float gelu_tanh1(float x) {
    const float t = x * (0.7978845608028654f + 0.035677408136300125f * x * x);
    const float e = __builtin_amdgcn_exp2f(t * -2.8853900817779268f);
    return x * __builtin_amdgcn_rcpf(1.0f + e);
}
__device__ __forceinline__ f32x4 gelu4(const f32x4 v) { return (f32x4){gelu_tanh1(v[0]), gelu_tanh1(v[1]), gelu_tanh1(v[2]), gelu_tanh1(v[3])}; }
__device__ __forceinline__ void st_bf16x4(bf16_t* p, const f32x4 v) { u32x2 w; w.x = cvt_pk_bf16(v[0], v[1]); w.y = cvt_pk_bf16(v[2], v[3]); *(u32x2*)p = w; }

struct EpiIn {
    static constexpr bool PERM = false, AFTER_DRAIN = false;
    const float* ssq; const float* cos64; const float* sin64; const float* cos32; const float* sin32;
    const float* gq; const float* gk; const float* gki;
    bf16_t* Q; bf16_t* Kb; bf16_t* Vb; float* Qi; float* Ki; float* Wi; bf16_t* U; bf16_t* VBg; float* ssqv; bf16_t* Qib; bf16_t* Kib;
    __device__ __forceinline__ void operator()(const f32x4 (&acc)[2][2][4][2], const Unit& u, int wr, int wc, int fr, int fq) const {
        const int pn = u.pn;
        const int rowb = u.pm * BM + wr * 64 + fr;
        if (pn < 2 || (pn == 2 && wc == 0)) {
            const float* g = pn < 2 ? gq : gk;
            const f32x4 g00 = *(const f32x4*)(g + 4 * fq), g01 = *(const f32x4*)(g + 16 + 4 * fq), g10 = *(const f32x4*)(g + 32 + 4 * fq), g11 = *(const f32x4*)(g + 48 + 4 * fq);
            const float osc = pn < 2 ? 0.125f : 1.0f;
#pragma unroll
            for (int ai = 0; ai < 2; ++ai)
#pragma unroll
                for (int m = 0; m < 4; ++m) {
                    const int row = rowb + ai * HALF + m * 16; const float ri = row_rinv(ssq, row);
                    const f32x4 v00 = acc[ai][0][m][0] * ri, v01 = acc[ai][0][m][1] * ri, v10 = acc[ai][1][m][0] * ri, v11 = acc[ai][1][m][1] * ri;
                    float ss = (dot4(v00) + dot4(v01)) + (dot4(v10) + dot4(v11));
                    ss += __shfl_xor(ss, 16); ss += __shfl_xor(ss, 32);
                    const float rn = __builtin_amdgcn_rsqf(ss * (1.0f / 64.0f) + RMS_EPS) * osc;
                    const f32x4 y00 = v00 * rn * g00, y01 = v01 * rn * g01, y10 = v10 * rn * g10, y11 = v11 * rn * g11;
                    const f32x4 c0 = *(const f32x4*)(cos64 + (size_t)row * 32 + 4 * fq), c1 = *(const f32x4*)(cos64 + (size_t)row * 32 + 16 + 4 * fq);
                    const f32x4 s0 = *(const f32x4*)(sin64 + (size_t)row * 32 + 4 * fq), s1 = *(const f32x4*)(sin64 + (size_t)row * 32 + 16 + 4 * fq);
                    const f32x4 o00 = y00 * c0 - y10 * s0, o10 = y10 * c0 + y00 * s0, o01 = y01 * c1 - y11 * s1, o11 = y11 * c1 + y01 * s1;
                    bf16_t* dst = pn < 2 ? Q + (size_t)row * 512 + (4 * pn + wc) * 64 + 4 * fq : Kb + (size_t)row * 64 + 4 * fq;
                    st_bf16x4(dst, o00); st_bf16x4(dst + 16, o01); st_bf16x4(dst + 32, o10); st_bf16x4(dst + 48, o11);
                }
        } else if (pn == 2) {
            if (wc == 1) {
#pragma unroll
                for (int ai = 0; ai < 2; ++ai)
#pragma unroll
                    for (int m = 0; m < 4; ++m) {
                        const int row = rowb + ai * HALF + m * 16; const float ri = row_rinv(ssq, row);
                        bf16_t* dst = Vb + (size_t)row * 64 + 4 * fq;
                        st_bf16x4(dst, acc[ai][0][m][0] * ri); st_bf16x4(dst + 16, acc[ai][0][m][1] * ri); st_bf16x4(dst + 32, acc[ai][1][m][0] * ri); st_bf16x4(dst + 48, acc[ai][1][m][1] * ri);
                    }
            } else if (wc == 2) {
                const f32x4 g0 = *(const f32x4*)(gki + 4 * fq), g1 = *(const f32x4*)(gki + 16 + 4 * fq);
#pragma unroll
                for (int ai = 0; ai < 2; ++ai)
#pragma unroll
                    for (int m = 0; m < 4; ++m) {
                        const int row = rowb + ai * HALF + m * 16; const float ri = row_rinv(ssq, row);
                        const f32x4 v0 = acc[ai][0][m][0] * ri, v1 = acc[ai][1][m][0] * ri;
                        float ss = dot4(v0) + dot4(v1);
                        ss += __shfl_xor(ss, 16); ss += __shfl_xor(ss, 32);
                        const float rn = __builtin_amdgcn_rsqf(ss * (1.0f / 32.0f) + RMS_EPS);
                        const f32x4 y0 = v0 * rn * g0, y1 = v1 * rn * g1;
                        const f32x4 c = *(const f32x4*)(cos32 + (size_t)row * 16 + 4 * fq), s = *(const f32x4*)(sin32 + (size_t)row * 16 + 4 * fq);
                        const f32x4 k0 = y0 * c - y1 * s, k1 = y1 * c + y0 * s;
                        *(f32x4*)(Ki + (size_t)row * 32 + 4 * fq) = k0; *(f32x4*)(Ki + (size_t)row * 32 + 16 + 4 * fq) = k1;
                        st_bf16x4(Kib + (size_t)row * 32 + 4 * fq, k0); st_bf16x4(Kib + (size_t)row * 32 + 16 + 4 * fq, k1);
                        if (fq < 2) *(f32x4*)(Wi + (size_t)row * 8 + 4 * fq) = acc[ai][0][m][1] * (ri * 0.0625f);
                    }
            }
        } else if (pn == 3) {
#pragma unroll
            for (int ai = 0; ai < 2; ++ai)
#pragma unroll
                for (int m = 0; m < 4; ++m) {
                    const int row = rowb + ai * HALF + m * 16; const float ri = row_rinv(ssq, row);
                    const f32x4 c = *(const f32x4*)(cos32 + (size_t)row * 16 + 4 * fq), s = *(const f32x4*)(sin32 + (size_t)row * 16 + 4 * fq);
#pragma unroll
                    for (int n = 0; n < 2; ++n) {
                        const f32x4 x1 = acc[ai][0][m][n] * ri, x2 = acc[ai][1][m][n] * ri;
                        const size_t qo = (size_t)row * 256 + (2 * wc + n) * 32 + 4 * fq;
                        const f32x4 q0 = x1 * c - x2 * s, q1 = x2 * c + x1 * s;
                        *(f32x4*)(Qi + qo) = q0; *(f32x4*)(Qi + qo + 16) = q1; st_bf16x4(Qib + qo, q0); st_bf16x4(Qib + qo + 16, q1);
                    }
                }
        } else {
            const bool isv = pn >= 6;
            bf16_t* O = isv ? VBg : U; const int colt = (pn & 1) * 256 + wc * 32 + 4 * fq;
#pragma unroll
            for (int ai = 0; ai < 2; ++ai)
#pragma unroll
                for (int m = 0; m < 4; ++m) {
                    const int row = rowb + ai * HALF + m * 16; const float ri = row_rinv(ssq, row);
                    float ss = 0.f;
#pragma unroll
                    for (int bj = 0; bj < 2; ++bj)
#pragma unroll
                        for (int n = 0; n < 2; ++n) { const f32x4 gv = gelu4(acc[ai][bj][m][n] * ri); ss += dot4(gv); st_bf16x4(O + (size_t)row * 512 + colt + bj * HALF + n * 16, gv); }
                    if (isv) { ss += __shfl_xor(ss, 16); ss += __shfl_xor(ss, 32); if (fq == 0) ssqv[(size_t)row * 8 + (pn - 6) * 4 + wc] = ss; }
                }
        }
    }
};
struct EpiRes {
    static constexpr bool PERM = false, AFTER_DRAIN = false;
    const float* base; float* out; bf16_t* xb; float* ssq;
    __device__ __forceinline__ void operator()(const f32x4 (&acc)[2][2][4][2], const Unit& u, int wr, int wc, int fr, int fq) const {
        const int rowb = u.pm * BM + wr * 64 + fr, col0 = u.pn * BM + wc * 32 + 4 * fq;
#pragma unroll
        for (int ai = 0; ai < 2; ++ai)
#pragma unroll
            for (int m = 0; m < 4; ++m) {
                const int row = rowb + ai * HALF + m * 16; const size_t off = (size_t)row * 1024 + col0; float ss = 0.f;
#pragma unroll
                for (int bj = 0; bj < 2; ++bj)
#pragma unroll
                    for (int n = 0; n < 2; ++n) { const size_t o2 = off + bj * HALF + n * 16; const f32x4 o = *(const f32x4*)(base + o2) + acc[ai][bj][m][n]; *(f32x4*)(out + o2) = o; ss += dot4(o); if (xb) st_bf16x4(xb + o2, o); }
                if (ssq) { ss += __shfl_xor(ss, 16); ss += __shfl_xor(ss, 32); if (fq == 0) ssq[(size_t)row * 16 + u.pn * 4 + wc] = ss; }
            }
    }
};
struct EpiUp {
    static constexpr bool PERM = true, AFTER_DRAIN = false;
    const float* ssq; bf16_t* O; int ldc;
    __device__ __forceinline__ void operator()(const f32x4 (&acc)[2][2][4][2], const Unit& u, int wr, int wc, int fr, int fq) const {
        const int rowb = u.pm * BM + wr * 64 + fr, col0 = u.pn * BM + wc * 32 + 8 * fq;
#pragma unroll
        for (int ai = 0; ai < 2; ++ai)
#pragma unroll
            for (int m = 0; m < 4; ++m) {
                const int row = rowb + ai * HALF + m * 16; const float ri = row_rinv(ssq, row); bf16_t* rowp = O + (size_t)row * ldc + col0;
#pragma unroll
                for (int bj = 0; bj < 2; ++bj) {
                    f32x4 v0 = acc[ai][bj][m][0] * ri, v1 = acc[ai][bj][m][1] * ri;
#pragma unroll
                    for (int i = 0; i < 4; ++i) { const float a = fmaxf(v0[i], 0.f), b = fmaxf(v1[i], 0.f); v0[i] = a * a; v1[i] = b * b; }
                    u32x4 w; w.x = cvt_pk_bf16(v0[0], v0[1]); w.y = cvt_pk_bf16(v0[2], v0[3]); w.z = cvt_pk_bf16(v1[0], v1[1]); w.w = cvt_pk_bf16(v1[2], v1[3]);
                    *(u32x4*)(rowp + bj * HALF) = w;
                }
            }
    }
};
struct EpiGlu {
    static constexpr bool PERM = false, AFTER_DRAIN = false;
    const float* ssq; bf16_t* Y;
    __device__ __forceinline__ void operator()(const f32x4 (&acc)[2][2][4][2], const Unit& u, int wr, int wc, int fr, int fq) const {
        const int rowb = u.pm * BM + wr * 64 + fr, col0 = u.pn * HALF + wc * 32 + 4 * fq;
#pragma unroll
        for (int ai = 0; ai < 2; ++ai)
#pragma unroll
            for (int m = 0; m < 4; ++m) {
                const int row = rowb + ai * HALF + m * 16; const float ri = row_rinv(ssq, row);
#pragma unroll
                for (int n = 0; n < 2; ++n) {
                    const f32x4 a = acc[ai][0][m][n] * ri, b = acc[ai][1][m][n] * ri; f32x4 y;
#pragma unroll
                    for (int i = 0; i < 4; ++i) y[i] = a[i] * __builtin_amdgcn_rcpf(1.0f + __builtin_amdgcn_exp2f(b[i] * -1.4426950408889634f));
                    st_bf16x4(Y + (size_t)row * 1024 + col0 + n * 16, y);
                }
            }
    }
};
template <class Epi, class Sched, bool ALIGN_EPI = false, bool SP2 = false>
__device__ __forceinline__ void gemm_phase(PG8_LAS unsigned char* lds, const Gemm g, const Sched& S, const Epi& E) {
    const int tid = threadIdx.x, wid = __builtin_amdgcn_readfirstlane(tid >> 6), lane = tid & 63, wr = wid >> 2, wc = wid & 3, fr = lane & 15, fq = lane >> 4;
    const int K = g.K, nt = K / BK;
    unsigned voffA[2], voffB[2];
#pragma unroll
    for (int i = 0; i < 2; ++i) { int R, C; stage_rc(tid * 16 + i * 8192, R, C); const int Rb = Epi::PERM ? ((R & ~31) + perm32(R & 31)) : R;
        voffA[i] = (unsigned)(R * K + C) * 2u; voffB[i] = (unsigned)(Rb * K + C) * 2u; }
    const size_t kstep = (size_t)(BK * 2);
    const size_t hstep = (size_t)HALF * K * 2;
    const size_t tstep = 2 * hstep;
    const unsigned ldsw = (unsigned)wid * 1024u;
    const int aoff = lds_byte(wr * 64 + fr, fq * 8), boff = lds_byte(wc * 32 + fr, fq * 8);
#define PG8_SA(b, h) (((b) * 2 + (h)) * HTB)
#define PG8_SB(b, h) ((4 + (b) * 2 + (h)) * HTB)
#define PG8_STAGE(bufoff, gbase, voff) do { _Pragma("unroll") for (int _i = 0; _i < 2; ++_i) \
        __builtin_amdgcn_global_load_lds((const unsigned*)((const char*)(gbase) + (voff)[_i]), (PG8_LAS unsigned*)(lds + (bufoff) + ldsw + _i * 8192), 16, 0, 0); } while (0)
#define PG8_LDA(dst, b, h) do { _Pragma("unroll") for (int m = 0; m < 4; ++m) _Pragma("unroll") for (int k = 0; k < 2; ++k) dst[m][k] = *(const PG8_LAS bf16x8*)(lds + PG8_SA(b, h) + aoff + m * 2048 + k * 1024); } while (0)
#define PG8_LDB(dst, b, h) do { _Pragma("unroll") for (int n = 0; n < 2; ++n) _Pragma("unroll") for (int k = 0; k < 2; ++k) dst[n][k] = *(const PG8_LAS bf16x8*)(lds + PG8_SB(b, h) + boff + n * 2048 + k * 1024); } while (0)
#define PG8_MMA(ai, bj, At, Bt) do { __builtin_amdgcn_s_setprio(1); _Pragma("unroll") for (int m = 0; m < 4; ++m) _Pragma("unroll") for (int n = 0; n < 2; ++n) _Pragma("unroll") for (int k = 0; k < 2; ++k) \
        acc[ai][bj][m][n] = __builtin_amdgcn_mfma_f32_16x16x32_bf16(Bt[n][k], At[m][k], acc[ai][bj][m][n], 0, 0, 0); __builtin_amdgcn_s_setprio(0); } while (0)
#define PG8_WAIT_V(n) asm volatile("s_waitcnt vmcnt(" #n ")" ::: "memory")
#define PG8_WAIT_L(n) asm volatile("s_waitcnt lgkmcnt(" #n ")" ::: "memory")
#define PG8_BAR __builtin_amdgcn_s_barrier()
#define PG8_SCHED __builtin_amdgcn_sched_barrier(0)
    Unit cur, nxt; int ui = 0;
    if (!S.next(0, cur)) return;
    f32x4 acc[2][2][4][2];
#pragma unroll
    for (int a = 0; a < 2; ++a)
#pragma unroll
        for (int b = 0; b < 2; ++b)
#pragma unroll
            for (int m = 0; m < 4; ++m)
#pragma unroll
                for (int n = 0; n < 2; ++n) acc[a][b][m][n] = (f32x4){0.f, 0.f, 0.f, 0.f};
    bf16x8 At[4][2], B0[2][2], B1[2][2];
    const char* cA = (const char*)g.A + (size_t)cur.pm * tstep; const char* cB = (const char*)g.Bt + (size_t)cur.pn * tstep;
    S.a_ready(cur);
    if constexpr (SP2) {
        PG8_STAGE(PG8_SB(0, 0), cB, voffB); PG8_STAGE(PG8_SB(0, 1), cB + hstep, voffB); PG8_STAGE(PG8_SA(0, 0), cA, voffA); PG8_STAGE(PG8_SA(0, 1), cA + hstep, voffA);
        if (wr == 1) PG8_BAR;
        PG8_WAIT_V(2); PG8_BAR;
        PG8_STAGE(PG8_SB(1, 0), cB + kstep, voffB); PG8_STAGE(PG8_SA(1, 0), cA + kstep, voffA); PG8_STAGE(PG8_SB(1, 1), cB + hstep + kstep, voffB);
        PG8_WAIT_V(6); PG8_BAR;
    } else {
        PG8_STAGE(PG8_SB(0, 0), cB, voffB); PG8_STAGE(PG8_SA(0, 0), cA, voffA); PG8_STAGE(PG8_SB(0, 1), cB + hstep, voffB); PG8_STAGE(PG8_SA(0, 1), cA + hstep, voffA);
        if (wr == 1) PG8_BAR;
        PG8_WAIT_V(4); PG8_BAR;
        PG8_STAGE(PG8_SB(1, 0), cB + kstep, voffB); PG8_STAGE(PG8_SA(1, 0), cA + kstep, voffA); PG8_STAGE(PG8_SB(1, 1), cB + hstep + kstep, voffB);
        PG8_WAIT_V(6); PG8_BAR;
    }
    for (;;) {
        const bool has_next = S.next(ui + 1, nxt);
        const char* nA = has_next ? (const char*)g.A + (size_t)nxt.pm * tstep : cA; const char* nB = has_next ? (const char*)g.Bt + (size_t)nxt.pn * tstep : cB;
        for (int t = 0; t < nt; t += 2) {
            const bool last = (t == nt - 2);
            const char* a1 = cA + (size_t)(t + 1) * kstep;
            const char* a2 = last ? nA : cA + (size_t)(t + 2) * kstep; const char* b2 = last ? nB : cB + (size_t)(t + 2) * kstep;
            const char* a3 = a2 + kstep; const char* b3 = b2 + kstep;
            if (last && has_next) S.a_ready(nxt);
            if constexpr (SP2) {
            PG8_LDB(B0, 0, 0); PG8_LDB(B1, 0, 1); PG8_SCHED; PG8_LDA(At, 0, 0); PG8_STAGE(PG8_SA(1, 1), a1 + hstep, voffA);
            PG8_WAIT_V(8); PG8_WAIT_L(0); PG8_BAR; PG8_MMA(0, 0, At, B0); PG8_MMA(0, 1, At, B1); PG8_BAR; PG8_SCHED;
            PG8_LDA(At, 0, 1); PG8_STAGE(PG8_SB(0, 0), b2, voffB); PG8_STAGE(PG8_SB(0, 1), b2 + hstep, voffB); PG8_STAGE(PG8_SA(0, 0), a2, voffA);
            PG8_WAIT_V(8); PG8_WAIT_L(0); PG8_BAR; PG8_MMA(1, 0, At, B0); PG8_MMA(1, 1, At, B1); PG8_BAR; PG8_SCHED;
            PG8_LDB(B0, 1, 0); PG8_LDB(B1, 1, 1); PG8_SCHED; PG8_LDA(At, 1, 0); PG8_STAGE(PG8_SA(0, 1), a2 + hstep, voffA);
            PG8_WAIT_V(8); PG8_WAIT_L(0); PG8_BAR; PG8_MMA(0, 0, At, B0); PG8_MMA(0, 1, At, B1); PG8_BAR; PG8_SCHED;
            PG8_LDA(At, 1, 1); PG8_STAGE(PG8_SB(1, 0), b3, voffB); PG8_STAGE(PG8_SB(1, 1), b3 + hstep, voffB); PG8_STAGE(PG8_SA(1, 0), a3, voffA);
            PG8_WAIT_V(8); PG8_WAIT_L(0); PG8_BAR; PG8_MMA(1, 0, At, B0); PG8_MMA(1, 1, At, B1); PG8_BAR; PG8_SCHED;
            } else {
            PG8_LDB(B0, 0, 0); PG8_SCHED; PG8_LDA(At, 0, 0); PG8_STAGE(PG8_SA(1, 1), a1 + hstep, voffA);
            PG8_WAIT_L(8); PG8_BAR; PG8_WAIT_L(0); PG8_MMA(0, 0, At, B0); PG8_BAR; PG8_SCHED;
            PG8_LDB(B1, 0, 1); PG8_STAGE(PG8_SB(0, 0), b2, voffB);
            PG8_BAR; PG8_WAIT_L(0); PG8_MMA(0, 1, At, B1); PG8_BAR;
            PG8_LDA(At, 0, 1); PG8_STAGE(PG8_SA(0, 0), a2, voffA);
            PG8_BAR; PG8_WAIT_L(0); PG8_MMA(1, 0, At, B0); PG8_BAR; PG8_SCHED;
            PG8_STAGE(PG8_SB(0, 1), b2 + hstep, voffB);
            PG8_WAIT_V(6); PG8_BAR; PG8_MMA(1, 1, At, B1); PG8_BAR;
            PG8_LDB(B0, 1, 0); PG8_SCHED; PG8_LDA(At, 1, 0); PG8_STAGE(PG8_SA(0, 1), a2 + hstep, voffA);
            PG8_WAIT_L(8); PG8_BAR; PG8_WAIT_L(0); PG8_MMA(0, 0, At, B0); PG8_BAR; PG8_SCHED;
            PG8_LDB(B1, 1, 1); PG8_STAGE(PG8_SB(1, 0), b3, voffB);
            PG8_BAR; PG8_WAIT_L(0); PG8_MMA(0, 1, At, B1); PG8_BAR;
            PG8_LDA(At, 1, 1); PG8_STAGE(PG8_SA(1, 0), a3, voffA);
            PG8_BAR; PG8_WAIT_L(0); PG8_MMA(1, 0, At, B0); PG8_BAR; PG8_SCHED;
            PG8_STAGE(PG8_SB(1, 1), b3 + hstep, voffB);
            PG8_WAIT_V(6); PG8_BAR; PG8_MMA(1, 1, At, B1); PG8_BAR;
            }
        }
        if constexpr (ALIGN_EPI) { if (wr == 0) PG8_BAR; }
        if constexpr (!Epi::AFTER_DRAIN) { E(acc, cur, wr, wc, fr, fq); S.done(cur); }
        if (!has_next) break;
#pragma unroll
        for (int a = 0; a < 2; ++a)
#pragma unroll
            for (int b = 0; b < 2; ++b)
#pragma unroll
                for (int m = 0; m < 4; ++m)
#pragma unroll
                    for (int n = 0; n < 2; ++n) acc[a][b][m][n] = (f32x4){0.f, 0.f, 0.f, 0.f};
        cur = nxt; cA = nA; cB = nB; ++ui;
        if constexpr (ALIGN_EPI) { if (wr == 1) PG8_BAR; }
    }
    PG8_WAIT_V(0);
    if constexpr (!ALIGN_EPI) { if (wr == 0) PG8_BAR; }
    PG8_BAR;
    if constexpr (Epi::AFTER_DRAIN) { E.fused(acc, cur, wr, wc, fr, fq, lds, wid, lane); S.done(cur); }
#undef PG8_SA
#undef PG8_SB
#undef PG8_STAGE
#undef PG8_LDA
#undef PG8_LDB
#undef PG8_MMA
#undef PG8_WAIT_V
#undef PG8_WAIT_L
#undef PG8_BAR
#undef PG8_SCHED
}
}

constexpr int NWAVES = 8;
constexpr int BATCH = 4, SEQ = 8192, D = 1024, M = BATCH * SEQ;
constexpr int NH = 8, HD = 64, WA = 512, NIH = 8, IDD = 32, TOPK = 256, WB = 512, NG = 8, GD = 64, CHUNK = 128;
constexpr int INW = 1960, INWP = 2048, FF = 4096, CW = 31;
constexpr float EPS = 1e-6f;
#ifndef MK_ONE_LAUNCH
#define MK_ONE_LAUNCH 1
#endif
constexpr int N_PHASES = 11;

constexpr size_t MiB = 1u << 20;
constexpr size_t WS_CTL = 0, CTL_ZERO_BYTES = 1 * MiB;
constexpr size_t WS_WIN = 1 * MiB;
constexpr size_t WS_WOUT = 5 * MiB;
constexpr size_t WS_W1 = 7 * MiB;
constexpr size_t WS_W2 = 23 * MiB;
constexpr size_t WS_WPW1 = 39 * MiB;
constexpr size_t WS_WPW2 = 43 * MiB;
constexpr size_t WS_SSQ = 45 * MiB;
constexpr size_t WS_COS64 = 47 * MiB, WS_SIN64 = 51 * MiB;
constexpr size_t WS_COS32 = 55 * MiB, WS_SIN32 = 57 * MiB;
constexpr size_t WS_XB = 59 * MiB;
constexpr size_t WS_BIG = 123 * MiB;
constexpr size_t WS_Q = WS_BIG;
constexpr size_t WS_QI = WS_BIG + 32 * MiB;
constexpr size_t WS_U = WS_BIG + 64 * MiB;
constexpr size_t WS_VBG = WS_BIG + 96 * MiB;
constexpr size_t WS_MIX = WS_BIG + 128 * MiB;
constexpr size_t WS_KB = WS_BIG + 192 * MiB;
constexpr size_t WS_VB = WS_BIG + 196 * MiB;
constexpr size_t WS_KI = WS_BIG + 200 * MiB;
constexpr size_t WS_WI = WS_BIG + 204 * MiB;
constexpr size_t WS_SSQV = WS_BIG + 205 * MiB;
constexpr size_t WS_QIB = WS_BIG + 206 * MiB;
constexpr size_t WS_KIB = WS_BIG + 222 * MiB;
constexpr size_t WS_Y = WS_BIG;
constexpr size_t WS_YC = WS_BIG + 64 * MiB;
constexpr size_t WS_HID1 = WS_BIG;
constexpr size_t WS_END = WS_BIG + 256 * MiB;
constexpr int CW_BAR = 4096;

constexpr int RING_OFF = 0, RING_BYTES = 131072;
constexpr int LDSCTL_OFF = RING_BYTES, MISC_OFF = LDSCTL_OFF + 320;
constexpr int LDS_BYTES = 147456;

#define GAS __attribute__((address_space(1)))
#define LAS __attribute__((address_space(3)))
typedef unsigned short bf16;
typedef unsigned v4u __attribute__((ext_vector_type(4)));
typedef unsigned v2u __attribute__((ext_vector_type(2)));
typedef float f32x4 __attribute__((ext_vector_type(4)));
typedef GAS unsigned gu32;
#define RLX_AGENT __ATOMIC_RELAXED, __HIP_MEMORY_SCOPE_AGENT
#define LDS_WAIT() asm volatile("s_waitcnt lgkmcnt(0)" ::: "memory")
#define VM_WAIT() asm volatile("s_waitcnt vmcnt(0)" ::: "memory")
__device__ __forceinline__ unsigned f2bf(float f) { unsigned u = __builtin_bit_cast(unsigned, f); return (u + 0x7fffu + ((u >> 16) & 1u)) >> 16; }
__device__ __forceinline__ unsigned pk2(float lo, float hi) { return f2bf(lo) | (f2bf(hi) << 16); }
__device__ __forceinline__ float bf2f(unsigned short h) { return __builtin_bit_cast(float, (unsigned)h << 16); }
__device__ __forceinline__ float bflo(unsigned w) { return __builtin_bit_cast(float, w << 16); }
__device__ __forceinline__ float bfhi(unsigned w) { return __builtin_bit_cast(float, w & 0xffff0000u); }
#define XB_TMO      128
#define XB_XCNT(j)  (256  + 64 * (j))
#define XB_XSUB(j)  (1280 + 64 * (j))
#define XB_XGEN(j)  (2304 + 64 * (j))
#define XB_TOP      3328
#define XB_TOPGEN   3392
#define XCD_BAR_WORDS 3456
#define XB_SPIN_CAP (1u << 18)

__device__ __forceinline__ unsigned xb_ld(unsigned* p)              { return __hip_atomic_load(p, __ATOMIC_RELAXED, __HIP_MEMORY_SCOPE_AGENT); }
__device__ __forceinline__ unsigned xb_add(unsigned* p, unsigned v) { return __hip_atomic_fetch_add(p, v, __ATOMIC_RELAXED, __HIP_MEMORY_SCOPE_AGENT); }
__device__ __forceinline__ unsigned xb_xcc_id() { return (unsigned)__builtin_amdgcn_s_getreg((3 << 11) | 20) & 0xFu; }
#define XB_SPIN(cond, bar) do { unsigned _sp = 0; while (cond) { __builtin_amdgcn_s_sleep(1); \
    if ((++_sp & 255u) == 0u) { if (xb_ld(&(bar)[XB_TMO])) break; if (_sp > XB_SPIN_CAP) { atomicAdd(&(bar)[XB_TMO], 1u); break; } } } } while (0)

struct XcdBarrier {
    unsigned* bar; unsigned x;
    volatile LAS unsigned* st;
};

__device__ __forceinline__ XcdBarrier xcd_barrier_post(unsigned* bar, volatile LAS unsigned* st) {
    XcdBarrier b; b.bar = bar; b.x = xb_xcc_id(); b.st = st;
    if (threadIdx.x == 0) (void)xb_add(&bar[XB_XCNT(b.x)], 1u);
    return b;
}
__device__ __forceinline__ void xcd_barrier_complete(unsigned* bar, unsigned x, unsigned& nloc, unsigned& nx) {
    const unsigned G = gridDim.x * gridDim.y * gridDim.z;
    unsigned sum, cnt, mine, sp = 0u;
    for (;;) {
        sum = 0u; cnt = 0u; mine = 0u;
#pragma unroll
        for (unsigned j = 0; j < 16; ++j) { const unsigned c = xb_ld(&bar[XB_XCNT(j)]); sum += c; cnt += (c > 0u) ? 1u : 0u; mine = (j == x) ? c : mine; }
        if (sum == G) break;
        __builtin_amdgcn_s_sleep(1);
        if ((++sp & 255u) == 0u) { if (xb_ld(&bar[XB_TMO])) break; if (sp > XB_SPIN_CAP) { atomicAdd(&bar[XB_TMO], 1u); break; } }
    }
    nloc = mine > 0u ? mine : 1u; nx = cnt > 0u ? cnt : 1u;
}

__device__ __forceinline__ void xcd_barrier(const XcdBarrier& b) {
    asm volatile("s_waitcnt vmcnt(0)" ::: "memory");
    __syncthreads();
    if (threadIdx.x == 0) {
        unsigned* bar = b.bar;
        __builtin_amdgcn_s_waitcnt(0);
        unsigned nloc = b.st[0], nx = b.st[1];
        if (nloc == 0u) { xcd_barrier_complete(bar, b.x, nloc, nx); b.st[0] = nloc; b.st[1] = nx; }
        const unsigned old = xb_add(&bar[XB_XSUB(b.x)], 1u);
        const unsigned gen = old / nloc;
        if (old + 1u == (gen + 1u) * nloc) {
            __builtin_amdgcn_fence(__ATOMIC_RELEASE, "agent");
            asm volatile("s_waitcnt vmcnt(0)" ::: "memory");
            const unsigned og = xb_add(&bar[XB_TOP], 1u);
            const unsigned tg = og / nx;
            if (og + 1u == (tg + 1u) * nx) xb_add(&bar[XB_TOPGEN], 1u);
            else XB_SPIN(xb_ld(&bar[XB_TOPGEN]) == tg, bar);
            __builtin_amdgcn_fence(__ATOMIC_ACQUIRE, "agent");
            xb_add(&bar[XB_XGEN(b.x)], 1u);
            asm volatile("s_waitcnt vmcnt(0)" ::: "memory");
        } else {
            XB_SPIN(xb_ld(&bar[XB_XGEN(b.x)]) == gen, bar);
            __builtin_amdgcn_fence(__ATOMIC_ACQUIRE, "agent");
            asm volatile("s_waitcnt vmcnt(0)" ::: "memory");
        }
    }
    __syncthreads();
}

struct Args {
    const float* x; const int* pos; const float* ev_g_norm; const float* ev_w_in; const float* ev_g_q; const float* ev_g_k; const float* ev_g_kidx; const float* ev_g_vb;
    const float* ev_w_s; const float* ev_b_s; const float* ev_w_out; const float* od_g_norm; const float* od_w_pw1; const float* od_w_dw; const float* od_b_dw; const float* od_g_conv;
    const float* od_w_pw2; const float* ff_g_norm; const float* ff_w1; const float* ff_w2;
    float* out; unsigned char* ws;
    float invf64[32]; float invf32[16];
    int ph_lo, ph_hi;
};
struct Frame {
    LAS unsigned char* lds;
    volatile LAS unsigned* MISC;
    gu32* ctl;
    int tid, lane, wave;
    int vcu, G;
};

__device__ __forceinline__ float wave_sum(float v) {
#pragma unroll
    for (int o = 1; o < 64; o <<= 1) v += __shfl_xor(v, o);
    return v;
}
__device__ __forceinline__ float wave_max(float v) {
#pragma unroll
    for (int o = 1; o < 64; o <<= 1) v = fmaxf(v, __shfl_xor(v, o));
    return v;
}

__host__ __device__ __forceinline__ int in_src_col(int np) {
    const int pn = np >> 8, c = np & 255, bj = c >> 7, wc = (c >> 5) & 3, j = c & 31;
    if (pn < 2) return 64 * (4 * pn + wc) + 32 * bj + j;
    if (pn == 2) {
        if (wc == 0) return 512 + 32 * bj + j;
        if (wc == 1) return 576 + 32 * bj + j;
        if (wc == 2) { if (j < 16) return 896 + 16 * bj + j; if (bj == 0 && j < 24) return 928 + (j - 16); return -1; }
        return -1;
    }
    if (pn == 3) return 640 + 32 * (2 * wc + (j >> 4)) + 16 * bj + (j & 15);
    if (pn < 6) return 936 + 256 * (pn - 4) + c;
    return 1448 + 256 * (pn - 6) + c;
}
__host__ __device__ __forceinline__ int glu_src_col(int np) { const int pn = np >> 8, c = np & 255; return (c >> 7) * 1024 + 128 * pn + (c & 127); }

__device__ __forceinline__ void p0_transpose_item(const float* W, int K, int N, int NP, const float* gk, int mode, bf16* WT, LAS float* scr, int item, int lane) {
    const int nblk = NP / 32, kb = item / nblk, nb = item % nblk, k0 = 64 * kb, n0 = 32 * nb;
    const int np = n0 + (lane & 31);
    const int sc = mode == 0 ? np : (mode == 1 ? in_src_col(np) : glu_src_col(np));
#pragma unroll 8
    for (int i = 0; i < 32; ++i) { const int kk = 2 * i + (lane >> 5); float v = sc >= 0 ? W[(size_t)(k0 + kk) * N + sc] : 0.f; if (gk) v *= gk[k0 + kk]; scr[kk * 33 + (lane & 31)] = v; }
    LDS_WAIT(); asm volatile("" ::: "memory");
    const int c = lane & 7;
#pragma unroll
    for (int j = 0; j < 4; ++j) { const int n = (lane >> 3) + 8 * j; const LAS float* s = scr + (8 * c) * 33 + n;
        v4u o; o.x = pk2(s[0 * 33], s[1 * 33]); o.y = pk2(s[2 * 33], s[3 * 33]); o.z = pk2(s[4 * 33], s[5 * 33]); o.w = pk2(s[6 * 33], s[7 * 33]);
        *(GAS v4u*)(WT + (size_t)(n0 + n) * K + k0 + 8 * c) = o; }
    LDS_WAIT(); asm volatile("" ::: "memory");
}

__device__ __forceinline__ void sincos_acc(float ang, float& s, float& c) {
    const double a = (double)ang;
    const double q = __builtin_rint(a * 0.63661977236758134308);
    double r = __builtin_fma(-q, 1.57079632679489655800e+00, a);
    r = __builtin_fma(-q, 6.12323399573676603587e-17, r);
    const double r2 = r * r;
    double sp = 1.0 / 6227020800.0; sp = sp * r2 - 1.0 / 39916800.0; sp = sp * r2 + 1.0 / 362880.0; sp = sp * r2 - 1.0 / 5040.0; sp = sp * r2 + 1.0 / 120.0; sp = sp * r2 - 1.0 / 6.0; sp = sp * r2 * r + r;
    double cp = 1.0 / 479001600.0; cp = cp * r2 - 1.0 / 3628800.0; cp = cp * r2 + 1.0 / 40320.0; cp = cp * r2 - 1.0 / 720.0; cp = cp * r2 + 1.0 / 24.0; cp = cp * r2 - 0.5; cp = cp * r2 + 1.0;
    const int qi = (int)(long long)q & 3;
    const double ss = (qi & 1) ? cp : sp, cc = (qi & 1) ? sp : cp;
    s = (float)((qi & 2) ? -ss : ss);
    c = (float)(((qi + 1) & 2) ? -cc : cc);
}

__device__ __forceinline__ void p0_prologue(Frame& F, const Args& A) {
    unsigned char* ws = A.ws;
    LAS float* scr = (LAS float*)(F.lds + RING_OFF + F.wave * 16384);
    const int gw = F.vcu * NWAVES + F.wave, NGW = F.G * NWAVES;
    constexpr int I_IN = (D / 64) * (INWP / 32), I_OUT = (D / 64) * (D / 32), I_1 = (D / 64) * (FF / 32), I_2 = (FF / 64) * (D / 32), I_P1 = (D / 64) * (2 * D / 32), I_P2 = I_OUT;
    constexpr int NITEMS = I_IN + I_OUT + 2 * I_1 + 2 * I_2 + I_P1 + I_P2;
    for (int it = gw; it < NITEMS; it += NGW) {
        int r = it;
        if (r < I_IN) { p0_transpose_item(A.ev_w_in, D, INW, INWP, A.ev_g_norm, 1, (bf16*)(ws + WS_WIN), scr, r, F.lane); continue; } r -= I_IN;
        if (r < I_OUT) { p0_transpose_item(A.ev_w_out, D, D, D, nullptr, 0, (bf16*)(ws + WS_WOUT), scr, r, F.lane); continue; } r -= I_OUT;
        if (r < 2 * I_1) { const int l = r / I_1; p0_transpose_item(A.ff_w1 + (size_t)l * D * FF, D, FF, FF, A.ff_g_norm + l * D, 0, (bf16*)(ws + WS_W1) + (size_t)l * D * FF, scr, r % I_1, F.lane); continue; } r -= 2 * I_1;
        if (r < 2 * I_2) { const int l = r / I_2; p0_transpose_item(A.ff_w2 + (size_t)l * D * FF, FF, D, D, nullptr, 0, (bf16*)(ws + WS_W2) + (size_t)l * D * FF, scr, r % I_2, F.lane); continue; } r -= 2 * I_2;
        if (r < I_P1) { p0_transpose_item(A.od_w_pw1, D, 2 * D, 2 * D, A.od_g_norm, 2, (bf16*)(ws + WS_WPW1), scr, r, F.lane); continue; } r -= I_P1;
        p0_transpose_item(A.od_w_pw2, D, D, D, nullptr, 0, (bf16*)(ws + WS_WPW2), scr, r, F.lane);
    }
    bf16* XB = (bf16*)(ws + WS_XB); float* ssq = (float*)(ws + WS_SSQ);
    for (int m = gw; m < M; m += NGW) {
        const GAS f32x4* xr = (const GAS f32x4*)(A.x + (size_t)m * D) + F.lane;
        f32x4 v[4]; float s = 0.f;
#pragma unroll
        for (int j = 0; j < 4; ++j) { v[j] = xr[64 * j]; s += (v[j].x * v[j].x + v[j].y * v[j].y) + (v[j].z * v[j].z + v[j].w * v[j].w); }
        s = wave_sum(s);
        GAS unsigned long long* o8 = (GAS unsigned long long*)(XB + (size_t)m * D) + F.lane;
#pragma unroll
        for (int j = 0; j < 4; ++j) o8[64 * j] = (unsigned long long)pk2(v[j].x, v[j].y) | ((unsigned long long)pk2(v[j].z, v[j].w) << 32);
        if (F.lane < 16) ssq[(size_t)m * 16 + F.lane] = F.lane == 0 ? s : 0.f;
    }
    float* c64 = (float*)(ws + WS_COS64); float* s64 = (float*)(ws + WS_SIN64); float* c32 = (float*)(ws + WS_COS32); float* s32 = (float*)(ws + WS_SIN32);
    const int gt = F.vcu * (NWAVES * 64) + F.tid, NGT = F.G * NWAVES * 64;
    for (int e = gt; e < M * 32; e += NGT) { const int tok = e >> 5, i = e & 31; const float ang = (float)A.pos[tok] * A.invf64[i]; float s, c; sincos_acc(ang, s, c); c64[e] = c; s64[e] = s; }
    for (int e = gt; e < M * 16; e += NGT) { const int tok = e >> 4, i = e & 15; const float ang = (float)A.pos[tok] * A.invf32[i]; float s, c; sincos_acc(ang, s, c); c32[e] = c; s32[e] = s; }
}

__device__ __forceinline__ unsigned f2key(float f) { const unsigned u = __builtin_bit_cast(unsigned, f); return (u & 0x80000000u) ? ~u : (u | 0x80000000u); }

namespace dsa {
typedef short bf16x8 __attribute__((ext_vector_type(8)));
typedef short s16x4 __attribute__((ext_vector_type(4)));
typedef float f32x16 __attribute__((ext_vector_type(16)));
constexpr int QB = 32, CB = 64;
constexpr int L_HIST = 0;
constexpr int L_SEL = 65536;
constexpr int L_CAND = 81920;
constexpr int L_META = 98304;
constexpr int L_OST = 99328;
constexpr int L_MISC = 107520;
__device__ __forceinline__ int crow(int reg, int h) { return (reg & 3) + 8 * (reg >> 2) + 4 * h; }
}

__device__ __forceinline__ void simple_select(Frame& F, const Args& A, int tok, LAS unsigned short* sel) {
    unsigned char* ws = A.ws;
    const float* Qi = (const float*)(ws + WS_QI); const float* Ki = (const float*)(ws + WS_KI); const float* Wi = (const float*)(ws + WS_WI);
    LAS unsigned* keyL = (LAS unsigned*)(F.lds + dsa::L_HIST);
    LAS float* qiL = (LAS float*)(F.lds + dsa::L_HIST + 32768);
    LAS float* wiL = (LAS float*)(F.lds + dsa::L_HIST + 32768 + 1024);
    LAS unsigned* hist = (LAS unsigned*)(F.lds + dsa::L_HIST + 32768 + 2048);
    LAS unsigned* wtot = (LAS unsigned*)(F.lds + dsa::L_MISC);
    LAS unsigned* bc = (LAS unsigned*)(F.lds + dsa::L_MISC + 64);
    const int tid = F.tid, lane = F.lane, wave = F.wave;
    const int b = tok / SEQ, t = tok % SEQ, n = t + 1; const size_t kb0 = (size_t)b * SEQ;
    __syncthreads();
    if (tid < 256) qiL[tid] = Qi[(size_t)tok * 256 + tid];
    if (tid < 8) wiL[tid] = Wi[(size_t)tok * 8 + tid];
    __syncthreads();
    for (int s = tid; s < n; s += NWAVES * 64) {
        asm volatile("" ::: "memory");
        const f32x4* kp = (const f32x4*)(Ki + (kb0 + s) * 32);
        f32x4 kv[8];
#pragma unroll
        for (int j = 0; j < 8; ++j) kv[j] = kp[j];
        float sc = 0.f;
#pragma unroll
        for (int h = 0; h < 8; ++h) {
            float d = 0.f;
#pragma unroll
            for (int j = 0; j < 8; ++j) { const f32x4 qv = *(const LAS f32x4*)(qiL + h * 32 + 4 * j); d += kv[j].x * qv.x; d += kv[j].y * qv.y; d += kv[j].z * qv.z; d += kv[j].w * qv.w; }
            sc += wiL[h] * fmaxf(d, 0.f);
        }
        keyL[s] = f2key(sc);
    }
    unsigned prefix = 0u, mask = 0u, need = TOPK;
    for (int shift = 24; shift >= 0; shift -= 8) {
        if (tid < 256) hist[tid] = 0u;
        __syncthreads();
        for (int s = tid; s < n; s += NWAVES * 64) { const unsigned u = keyL[s]; if ((u & mask) == prefix) __hip_atomic_fetch_add(&hist[(u >> shift) & 255u], 1u, __ATOMIC_RELAXED, __HIP_MEMORY_SCOPE_WORKGROUP); }
        __syncthreads();
        if (wave == 0) {
            const unsigned h0 = hist[4 * lane], h1 = hist[4 * lane + 1], h2 = hist[4 * lane + 2], h3 = hist[4 * lane + 3];
            const unsigned c = h0 + h1 + h2 + h3;
            unsigned sfx = c;
#pragma unroll
            for (int o = 1; o < 64; o <<= 1) { const unsigned v = __shfl_down(sfx, o); if (lane + o < 64) sfx += v; }
            const unsigned above = sfx - c;
            if (above < need && sfx >= need) {
                unsigned rem = need - above, dsel, cab;
                if (h3 >= rem) { dsel = 3; cab = 0; } else if (h3 + h2 >= rem) { dsel = 2; cab = h3; } else if (h3 + h2 + h1 >= rem) { dsel = 1; cab = h3 + h2; } else { dsel = 0; cab = h3 + h2 + h1; }
                bc[0] = 4 * lane + dsel; bc[1] = rem - cab;
            }
        }
        __syncthreads();
        const unsigned dsel = bc[0]; need = bc[1];
        prefix |= dsel << shift; mask |= 255u << shift;
        __syncthreads();
    }
    const unsigned T = prefix, cgt = TOPK - need;
    unsigned run = 0u;
    for (int base = 0; base < n; base += NWAVES * 64) {
        const int s = base + tid; const unsigned u = s < n ? keyL[s] : 0u;
        const bool gt = s < n && u > T, eq = s < n && u == T;
        const unsigned long long bg = __ballot(gt), be = __ballot(eq);
        const unsigned long long lt = (1ull << lane) - 1ull;
        const unsigned pg = __popcll(bg & lt), pe = __popcll(be & lt);
        if (lane == 0) wtot[wave] = (unsigned)__popcll(bg) | ((unsigned)__popcll(be) << 16);
        __syncthreads();
        unsigned off = run, tot = 0u;
#pragma unroll
        for (int w = 0; w < NWAVES; ++w) { const unsigned v = wtot[w]; if (w < wave) off += v; tot += v; }
        if (gt) sel[(off & 0xffffu) + pg] = (unsigned short)s;
        if (eq) { const unsigned rk = (off >> 16) + pe; if (rk < need) sel[cgt + rk] = (unsigned short)s; }
        run += tot;
        __syncthreads();
    }
}

__device__ __forceinline__ void simple_attend(Frame& F, const Args& A, int tok, const LAS unsigned short* sel, int nsel) {
    unsigned char* ws = A.ws;
    const bf16* Qg = (const bf16*)(ws + WS_Q); const bf16* Kb = (const bf16*)(ws + WS_KB); const bf16* Vb = (const bf16*)(ws + WS_VB); bf16* MIX = (bf16*)(ws + WS_MIX);
    LAS float* qL = (LAS float*)(F.lds + dsa::L_HIST);
    LAS float* lg = (LAS float*)(F.lds + dsa::L_HIST + 2048);
    const int tid = F.tid, lane = F.lane, wave = F.wave;
    const size_t kb0 = (size_t)(tok / SEQ) * SEQ;
    __syncthreads();
    qL[tid] = bf2f(Qg[(size_t)tok * 512 + tid]);
    __syncthreads();
    {
        const int j = tid & 255, hh = tid >> 8;
        float l0 = -INFINITY, l1 = -INFINITY, l2 = -INFINITY, l3 = -INFINITY;
        if (j < nsel) {
            const v4u* kp = (const v4u*)(Kb + (kb0 + sel[j]) * 64);
            l0 = l1 = l2 = l3 = 0.f;
#pragma unroll 1
            for (int c = 0; c < 8; ++c) {
                asm volatile("" ::: "memory");
                const v4u kw = kp[c];
                const float k0 = bflo(kw.x), k1 = bfhi(kw.x), k2 = bflo(kw.y), k3 = bfhi(kw.y), k4 = bflo(kw.z), k5 = bfhi(kw.z), k6 = bflo(kw.w), k7 = bfhi(kw.w);
#pragma unroll
                for (int h = 0; h < 4; ++h) {
                    const LAS float* qp = qL + (4 * hh + h) * 64 + 8 * c;
                    const f32x4 qa = *(const LAS f32x4*)qp, qb = *(const LAS f32x4*)(qp + 4);
                    const float d = (k0 * qa.x + k1 * qa.y) + (k2 * qa.z + k3 * qa.w) + (k4 * qb.x + k5 * qb.y) + (k6 * qb.z + k7 * qb.w);
                    if (h == 0) l0 += d; else if (h == 1) l1 += d; else if (h == 2) l2 += d; else l3 += d;
                }
            }
        }
        lg[(4 * hh + 0) * 256 + j] = l0; lg[(4 * hh + 1) * 256 + j] = l1; lg[(4 * hh + 2) * 256 + j] = l2; lg[(4 * hh + 3) * 256 + j] = l3;
    }
    __syncthreads();
    {
        float v[4]; float mx = -INFINITY;
#pragma unroll
        for (int i = 0; i < 4; ++i) { v[i] = lg[wave * 256 + lane + 64 * i]; mx = fmaxf(mx, v[i]); }
        mx = wave_max(mx); float sm = 0.f;
#pragma unroll
        for (int i = 0; i < 4; ++i) { v[i] = __expf(v[i] - mx); sm += v[i]; }
        sm = wave_sum(sm); const float inv = 1.0f / sm;
#pragma unroll
        for (int i = 0; i < 4; ++i) lg[wave * 256 + lane + 64 * i] = v[i] * inv;
    }
    __syncthreads();
    {
        float o = 0.f;
#pragma unroll 4
        for (int j = 0; j < nsel; ++j) o += lg[wave * 256 + j] * bf2f(Vb[(kb0 + sel[j]) * 64 + lane]);
        MIX[(size_t)tok * 1024 + wave * 64 + lane] = (bf16)f2bf(o);
    }
}

template <int PASS>
__device__ __forceinline__ void idx_tile(const bf16* Kib_b, int kt, bool diag, int t0, const dsa::bf16x8 (&qf)[8][2], const float (&w)[8], LAS unsigned char* lds, int lane, float fb0, float fb1) {
    using namespace dsa;
    const int r = lane & 31, h = lane >> 5;
    const bf16* kp = Kib_b + (size_t)(32 * kt + r) * 32 + 8 * h;
    const bf16x8 a0 = *(const bf16x8*)kp, a1 = *(const bf16x8*)(kp + 16);
    f32x16 sc;
#pragma unroll
    for (int i = 0; i < 16; ++i) sc[i] = 0.f;
#pragma unroll
    for (int h8 = 0; h8 < 8; ++h8) {
        f32x16 acc;
#pragma unroll
        for (int i = 0; i < 16; ++i) acc[i] = 0.f;
        acc = __builtin_amdgcn_mfma_f32_32x32x16_bf16(a0, qf[h8][0], acc, 0, 0, 0);
        acc = __builtin_amdgcn_mfma_f32_32x32x16_bf16(a1, qf[h8][1], acc, 0, 0, 0);
#pragma unroll
        for (int i = 0; i < 16; ++i) sc[i] = fmaf(fmaxf(acc[i], 0.f), w[h8], sc[i]);
#pragma unroll
        for (int i = 0; i < 16; ++i) asm volatile("" : "+v"(sc[i]));
    }
    const int tq = t0 + r;
    if (PASS == 1) {
        LAS unsigned* hq = (LAS unsigned*)(lds + L_HIST) + r * 512;
#pragma unroll
        for (int i = 0; i < 16; ++i) {
            const int key = 32 * kt + crow(i, h);
            const bool ok = !diag || key <= tq;
            const float v = fminf(fmaxf(fmaf(sc[i], 64.f, 512.f), 0.f), 1023.f);
            const int bin = (int)v;
            if (ok) __hip_atomic_fetch_add(hq + (bin >> 1), (bin & 1) ? 65536u : 1u, __ATOMIC_RELAXED, __HIP_MEMORY_SCOPE_WORKGROUP);
        }
    } else {
        LAS unsigned* selcnt = (LAS unsigned*)(lds + L_META); LAS unsigned* candcnt = selcnt + 32;
        LAS unsigned short* selq = (LAS unsigned short*)(lds + L_SEL) + r * 256;
        LAS unsigned long long* candq = (LAS unsigned long long*)(lds + L_CAND) + r * CB;
#pragma unroll
        for (int i = 0; i < 16; ++i) {
            const int key = 32 * kt + crow(i, h);
            const bool ok = !diag || key <= tq;
            const float v = fmaf(sc[i], 64.f, 512.f);
            const bool above = ok && v >= fb1;
            const bool bnd = ok && !above && v >= fb0;
            if (above) { const unsigned slot = __hip_atomic_fetch_add(selcnt + r, 1u, __ATOMIC_RELAXED, __HIP_MEMORY_SCOPE_WORKGROUP); if (slot < 256u) selq[slot] = (unsigned short)key; }
            if (bnd) { const unsigned slot = __hip_atomic_fetch_add(candcnt + r, 1u, __ATOMIC_RELAXED, __HIP_MEMORY_SCOPE_WORKGROUP); if (slot < (unsigned)CB) candq[slot] = ((unsigned long long)__builtin_bit_cast(unsigned, sc[i]) << 32) | (unsigned)key; }
        }
    }
}

__device__ __forceinline__ void dsa_select_unit(Frame& F, const Args& A, int b, int qb) {
    using namespace dsa;
    unsigned char* ws = A.ws;
    const bf16* Qib = (const bf16*)(ws + WS_QIB); const bf16* Kib = (const bf16*)(ws + WS_KIB); const float* Wi = (const float*)(ws + WS_WI);
    const int tid = F.tid, lane = F.lane, wave = F.wave;
    const int t0 = 32 * qb, ntiles = qb + 1; const size_t kb0 = (size_t)b * SEQ; const size_t tok0 = kb0 + t0;
    LAS unsigned* meta = (LAS unsigned*)(F.lds + L_META);
    { LAS v4u* hz = (LAS v4u*)(F.lds + L_HIST);
#pragma unroll
      for (int i = 0; i < 8; ++i) hz[tid + 512 * i] = (v4u){0u, 0u, 0u, 0u};
      if (tid < 192) meta[tid] = 0u; }
    bf16x8 qf[8][2]; float w[8];
    { const bf16* qp = Qib + (tok0 + (lane & 31)) * 256 + 8 * (lane >> 5);
#pragma unroll
      for (int h8 = 0; h8 < 8; ++h8) { qf[h8][0] = *(const bf16x8*)(qp + h8 * 32); qf[h8][1] = *(const bf16x8*)(qp + h8 * 32 + 16); }
      const f32x4 wa = *(const f32x4*)(Wi + (tok0 + (lane & 31)) * 8), wb = *(const f32x4*)(Wi + (tok0 + (lane & 31)) * 8 + 4);
      w[0] = wa.x; w[1] = wa.y; w[2] = wa.z; w[3] = wa.w; w[4] = wb.x; w[5] = wb.y; w[6] = wb.z; w[7] = wb.w; }
    __syncthreads();
    const bf16* Kib_b = Kib + kb0 * 32;
    for (int kt = wave; kt < ntiles; kt += NWAVES) idx_tile<1>(Kib_b, kt, kt == ntiles - 1, t0, qf, w, F.lds, lane, 0.f, 0.f);
    __syncthreads();
#pragma unroll 1
    for (int qi4 = 0; qi4 < 4; ++qi4) {
        const int q = 4 * wave + qi4;
        const LAS v4u* hq = (const LAS v4u*)(F.lds + L_HIST + q * 2048) + 2 * lane;
        const v4u ha = hq[0], hb = hq[1];
        unsigned cnt[16];
        cnt[0] = ha.x & 0xffffu; cnt[1] = ha.x >> 16; cnt[2] = ha.y & 0xffffu; cnt[3] = ha.y >> 16; cnt[4] = ha.z & 0xffffu; cnt[5] = ha.z >> 16; cnt[6] = ha.w & 0xffffu; cnt[7] = ha.w >> 16;
        cnt[8] = hb.x & 0xffffu; cnt[9] = hb.x >> 16; cnt[10] = hb.y & 0xffffu; cnt[11] = hb.y >> 16; cnt[12] = hb.z & 0xffffu; cnt[13] = hb.z >> 16; cnt[14] = hb.w & 0xffffu; cnt[15] = hb.w >> 16;
        unsigned c = 0u;
#pragma unroll
        for (int k = 0; k < 16; ++k) c += cnt[k];
        unsigned sfx = c;
#pragma unroll
        for (int o = 1; o < 64; o <<= 1) { const unsigned v = __shfl_down(sfx, o); if (lane + o < 64) sfx += v; }
        const unsigned above = sfx - c;
        if (above < (unsigned)TOPK && sfx >= (unsigned)TOPK) {
            unsigned cum = above; int bsel = 0; unsigned cab = 0u; bool found = false;
#pragma unroll
            for (int k = 15; k >= 0; --k) { if (!found && cum + cnt[k] >= (unsigned)TOPK) { bsel = 16 * lane + k; cab = cum; found = true; } cum += cnt[k]; }
            meta[64 + q] = __builtin_bit_cast(unsigned, bsel == 0 ? -INFINITY : (float)bsel);
            meta[96 + q] = __builtin_bit_cast(unsigned, bsel == 1023 ? INFINITY : (float)(bsel + 1));
            meta[128 + q] = (unsigned)TOPK - cab;
        }
    }
    __syncthreads();
    { const float fb0 = __builtin_bit_cast(float, meta[64 + (lane & 31)]), fb1 = __builtin_bit_cast(float, meta[96 + (lane & 31)]);
      for (int kt = wave; kt < ntiles; kt += NWAVES) idx_tile<2>(Kib_b, kt, kt == ntiles - 1, t0, qf, w, F.lds, lane, fb0, fb1); }
    __syncthreads();
#pragma unroll 1
    for (int qi4 = 0; qi4 < 4; ++qi4) {
        const int q = 4 * wave + qi4;
        const unsigned nsel0 = __builtin_amdgcn_readfirstlane(meta[q]), nc = __builtin_amdgcn_readfirstlane(meta[32 + q]), need = __builtin_amdgcn_readfirstlane(meta[128 + q]);
        const bool bad = nc > (unsigned)CB || nsel0 + need != (unsigned)TOPK || nc < need;
        if (bad) { if (lane == 0) meta[160 + q] = 1u; continue; }
        const unsigned long long me = (unsigned)lane < nc ? ((const LAS unsigned long long*)(F.lds + L_CAND))[q * CB + lane] : 0ull;
        const unsigned mk = f2key(__builtin_bit_cast(float, (unsigned)(me >> 32))), mi = (unsigned)me & 0xffffu;
        unsigned rank = 0u;
        for (unsigned m = 0; m < nc; ++m) {
            const unsigned ok = __builtin_amdgcn_readlane(mk, m), oi = __builtin_amdgcn_readlane(mi, m);
            rank += (ok > mk || (ok == mk && oi < mi)) ? 1u : 0u;
        }
        if ((unsigned)lane < nc && rank < need) ((LAS unsigned short*)(F.lds + L_SEL))[q * 256 + nsel0 + rank] = (unsigned short)mi;
    }
    __syncthreads();
    for (int q = 0; q < 32; ++q) if (meta[160 + q] != 0u) simple_select(F, A, (int)(tok0 + q), (LAS unsigned short*)(F.lds + L_SEL) + q * 256);
    __syncthreads();
}


#define DSA_TR8(l0, h0, l1, h1, l2, h2, l3, h3, a0, a1, a2, a3) asm volatile( \
    "ds_read_b64_tr_b16 %0, %8\n\tds_read_b64_tr_b16 %1, %8 offset:2048\n\tds_read_b64_tr_b16 %2, %9\n\tds_read_b64_tr_b16 %3, %9 offset:2048\n\t" \
    "ds_read_b64_tr_b16 %4, %10\n\tds_read_b64_tr_b16 %5, %10 offset:2048\n\tds_read_b64_tr_b16 %6, %11\n\tds_read_b64_tr_b16 %7, %11 offset:2048\n\ts_waitcnt lgkmcnt(0)" \
    : "=&v"(l0), "=&v"(h0), "=&v"(l1), "=&v"(h1), "=&v"(l2), "=&v"(h2), "=&v"(l3), "=&v"(h3) : "v"(a0), "v"(a1), "v"(a2), "v"(a3) : "memory")
__device__ __forceinline__ void attend_query(const Args& A, LAS unsigned char* lds, int wave, int lane, size_t tok, size_t kb0, const LAS unsigned short* selq, int nsel) {
    using namespace dsa;
    unsigned char* ws = A.ws;
    const bf16* Qg = (const bf16*)(ws + WS_Q); const bf16* Kb = (const bf16*)(ws + WS_KB); const bf16* Vb = (const bf16*)(ws + WS_VB); bf16* MIX = (bf16*)(ws + WS_MIX);
    const int n16 = lane & 15, g = lane >> 4;
    bf16x8 qf0 = (bf16x8){0, 0, 0, 0, 0, 0, 0, 0}, qf1 = qf0;
    if (n16 < 8) { const bf16* qp = Qg + tok * 512 + n16 * 64 + 8 * g; qf0 = *(const bf16x8*)qp; qf1 = *(const bf16x8*)(qp + 32); }
    f32x4 s[16];
#pragma unroll
    for (int kt = 0; kt < 16; ++kt) {
        const int slot = 16 * kt + n16;
        const unsigned idx = slot < nsel ? (unsigned)selq[slot] : 0u;
        const bf16* kp = Kb + (kb0 + idx) * 64 + 8 * g;
        const bf16x8 a0 = *(const bf16x8*)kp, a1 = *(const bf16x8*)(kp + 32);
        f32x4 acc = (f32x4){0.f, 0.f, 0.f, 0.f};
        acc = __builtin_amdgcn_mfma_f32_16x16x32_bf16(a0, qf0, acc, 0, 0, 0);
        acc = __builtin_amdgcn_mfma_f32_16x16x32_bf16(a1, qf1, acc, 0, 0, 0);
        s[kt] = acc;
    }
    float mx = -INFINITY;
#pragma unroll
    for (int kt = 0; kt < 16; ++kt)
#pragma unroll
        for (int i = 0; i < 4; ++i) { const float v = (16 * kt + 4 * g + i) < nsel ? s[kt][i] : -INFINITY; s[kt][i] = v; mx = fmaxf(mx, v); }
    mx = fmaxf(mx, __shfl_xor(mx, 16)); mx = fmaxf(mx, __shfl_xor(mx, 32));
    float sum = 0.f;
#pragma unroll
    for (int kt = 0; kt < 16; ++kt)
#pragma unroll
        for (int i = 0; i < 4; ++i) { const float p = __builtin_amdgcn_exp2f((s[kt][i] - mx) * 1.4426950408889634f); s[kt][i] = p; sum += p; }
    sum += __shfl_xor(sum, 16); sum += __shfl_xor(sum, 32);
    bf16x8 pf[8];
#pragma unroll
    for (int s8 = 0; s8 < 8; ++s8) {
        v4u w; w.x = pg8::cvt_pk_bf16(s[2 * s8][0], s[2 * s8][1]); w.y = pg8::cvt_pk_bf16(s[2 * s8][2], s[2 * s8][3]); w.z = pg8::cvt_pk_bf16(s[2 * s8 + 1][0], s[2 * s8 + 1][1]); w.w = pg8::cvt_pk_bf16(s[2 * s8 + 1][2], s[2 * s8 + 1][3]);
        pf[s8] = __builtin_bit_cast(bf16x8, w);
    }
    LAS unsigned char* vst = lds + L_HIST + wave * 8192;
    const unsigned vbase = (unsigned)(size_t)vst;
    f32x4 o[4];
#pragma unroll
    for (int dt = 0; dt < 4; ++dt) o[dt] = (f32x4){0.f, 0.f, 0.f, 0.f};
#pragma unroll
    for (int c = 0; c < 4; ++c) {
#pragma unroll
        for (int it = 0; it < 8; ++it) {
            const int row = 8 * it + (lane >> 3), slot = 64 * c + row, ch = lane & 7;
            const unsigned idx = slot < nsel ? (unsigned)selq[slot] : 0u;
            const v4u v = *(const v4u*)(Vb + (kb0 + idx) * 64 + 8 * ch);
            *(LAS v4u*)(vst + row * 128 + (((ch >> 1) ^ ((row >> 1) & 3)) << 5) + ((ch & 1) << 4)) = v;
        }
        asm volatile("s_waitcnt lgkmcnt(0)" ::: "memory");
#pragma unroll
        for (int s2 = 0; s2 < 2; ++s2) {
            const int r1 = 32 * s2 + 4 * g + (n16 >> 2), sw = (r1 >> 1) & 3;
            const unsigned ab = vbase + (unsigned)(r1 * 128 + 8 * (n16 & 3));
            const unsigned a0 = ab + (unsigned)((0 ^ sw) << 5), a1 = ab + (unsigned)((1 ^ sw) << 5), a2 = ab + (unsigned)((2 ^ sw) << 5), a3 = ab + (unsigned)((3 ^ sw) << 5);
            s16x4 l0, h0, l1, h1, l2, h2, l3, h3;
            DSA_TR8(l0, h0, l1, h1, l2, h2, l3, h3, a0, a1, a2, a3);
            const bf16x8 b0 = __builtin_shufflevector(l0, h0, 0, 1, 2, 3, 4, 5, 6, 7), b1 = __builtin_shufflevector(l1, h1, 0, 1, 2, 3, 4, 5, 6, 7);
            const bf16x8 b2 = __builtin_shufflevector(l2, h2, 0, 1, 2, 3, 4, 5, 6, 7), b3 = __builtin_shufflevector(l3, h3, 0, 1, 2, 3, 4, 5, 6, 7);
            o[0] = __builtin_amdgcn_mfma_f32_16x16x32_bf16(pf[2 * c + s2], b0, o[0], 0, 0, 0);
            o[1] = __builtin_amdgcn_mfma_f32_16x16x32_bf16(pf[2 * c + s2], b1, o[1], 0, 0, 0);
            o[2] = __builtin_amdgcn_mfma_f32_16x16x32_bf16(pf[2 * c + s2], b2, o[2], 0, 0, 0);
            o[3] = __builtin_amdgcn_mfma_f32_16x16x32_bf16(pf[2 * c + s2], b3, o[3], 0, 0, 0);
        }
    }
    const float inv = 1.0f / sum;
    float rs[4];
#pragma unroll
    for (int i = 0; i < 4; ++i) rs[i] = __shfl(inv, 4 * g + i);
    LAS unsigned short* ost = (LAS unsigned short*)(lds + L_OST + wave * 1024);
    if (g < 2) {
#pragma unroll
        for (int dt = 0; dt < 4; ++dt)
#pragma unroll
            for (int i = 0; i < 4; ++i) ost[(4 * g + i) * 64 + 16 * dt + n16] = (unsigned short)f2bf(o[dt][i] * rs[i]);
    }
    asm volatile("s_waitcnt lgkmcnt(0)" ::: "memory");
    const v4u ov = *(const LAS v4u*)((const LAS unsigned char*)ost + 16 * lane);
    *(v4u*)(MIX + tok * 1024 + 8 * lane) = ov;
}

__device__ __forceinline__ void dsa_unit(Frame& F, const Args& A, int b, int qb) {
    using namespace dsa;
    const int tid = F.tid;
    const int t0 = 32 * qb; const size_t tok0 = (size_t)b * SEQ + t0;
    __syncthreads();
    if (qb >= 8) dsa_select_unit(F, A, b, qb);
    else { LAS unsigned short* sel = (LAS unsigned short*)(F.lds + L_SEL); for (int e = tid; e < 32 * 256; e += NWAVES * 64) sel[e] = (unsigned short)(e & 255); __syncthreads(); }
#ifdef DSA_SIMPLE_ATTEND
    for (int q = 0; q < 32; ++q) { const int n = t0 + q + 1; simple_attend(F, A, (int)(tok0 + q), (const LAS unsigned short*)(F.lds + L_SEL) + q * 256, n < TOPK ? n : TOPK); }
#else
#pragma unroll 1
    for (int q = F.wave; q < 32; q += NWAVES) { const int n = t0 + q + 1; attend_query(A, F.lds, F.wave, F.lane, tok0 + q, (size_t)b * SEQ, (const LAS unsigned short*)(F.lds + L_SEL) + q * 256, n < TOPK ? n : TOPK); }
#endif
}

__device__ __forceinline__ void dsa_phase(Frame& F, const Args& A) {
    for (int P = F.vcu; P < 512; P += F.G) {
        const int b = P >> 7, j = P & 127;
        dsa_unit(F, A, b, j);
        dsa_unit(F, A, b, 255 - j);
    }
    __syncthreads();
}
__device__ __forceinline__ void gating_simple_phase(Frame& F, const Args& A) {
    unsigned char* ws = A.ws;
    const bf16* U = (const bf16*)(ws + WS_U); const bf16* VBg = (const bf16*)(ws + WS_VBG); const float* ssqv = (const float*)(ws + WS_SSQV);
    bf16* MIX = (bf16*)(ws + WS_MIX);
    LAS float* vv = (LAS float*)F.lds;
    const int tid = F.tid, lane = F.lane, wave = F.wave;
    for (int unit = F.vcu; unit < (M / CHUNK) * NG; unit += F.G) {
        const int c = unit >> 3, g = unit & 7; const size_t tok0 = (size_t)c * CHUNK;
        __syncthreads();
        for (int e = tid; e < CHUNK * GD; e += NWAVES * 64) {
            const int j = e >> 6, d = e & 63; const size_t tok = tok0 + j;
            const f32x4 a = *(const f32x4*)(ssqv + tok * 8), b2 = *(const f32x4*)(ssqv + tok * 8 + 4);
            const float ri = __builtin_amdgcn_rsqf((((a.x + a.y) + (a.z + a.w)) + ((b2.x + b2.y) + (b2.z + b2.w))) * (1.0f / 512.0f) + EPS);
            vv[e] = bf2f(VBg[tok * 512 + g * 64 + d]) * ri * A.ev_g_vb[g * 64 + d];
        }
        __syncthreads();
        const float* Wg = A.ev_w_s + (size_t)g * CHUNK * CHUNK;
        for (int r = 0; r < 16; ++r) {
            const int i = wave + 8 * r;
            const float* wrow = Wg + (size_t)i * CHUNK;
            float acc = 0.f;
            for (int j = 0; j <= i; ++j) acc += wrow[j] * vv[j * 64 + lane];
            const size_t tok = tok0 + i;
            const float sv = acc + A.ev_b_s[g * CHUNK + i];
            MIX[tok * 1024 + 512 + g * 64 + lane] = (bf16)f2bf(bf2f(U[tok * 512 + g * 64 + lane]) * sv);
        }
    }
    __syncthreads();
}

__device__ __forceinline__ void conv_simple_phase(Frame& F, const Args& A) {
    unsigned char* ws = A.ws;
    const bf16* Y = (const bf16*)(ws + WS_Y); bf16* YC = (bf16*)(ws + WS_YC);
    constexpr int TS = 16, ROWS = TS + CW - 1;
    LAS unsigned* yl = (LAS unsigned*)F.lds;
    LAS float* part = (LAS float*)(F.lds + ROWS * 2048);
    const int tid = F.tid, lane = F.lane, wave = F.wave;
    float w0[CW], w1[CW];
#pragma unroll
    for (int k = 0; k < CW; ++k) { w0[k] = A.od_w_dw[k * D + 2 * tid]; w1[k] = A.od_w_dw[k * D + 2 * tid + 1]; }
    const float b0 = A.od_b_dw[2 * tid], b1 = A.od_b_dw[2 * tid + 1], g0 = A.od_g_conv[2 * tid], g1 = A.od_g_conv[2 * tid + 1];
    for (int strip = F.vcu; strip < M / TS; strip += F.G) {
        const int tok0 = strip * TS, s0 = tok0 % SEQ;
        __syncthreads();
        for (int r = 0; r < ROWS; ++r) { const int s = s0 - (CW - 1) + r; yl[r * 512 + tid] = s >= 0 ? *(const unsigned*)(Y + (size_t)(tok0 - (CW - 1) + r) * D + 2 * tid) : 0u; }
        __syncthreads();
        float o0[TS], o1[TS];
#pragma unroll
        for (int tk = 0; tk < TS; ++tk) {
            float a0 = b0, a1 = b1;
#pragma unroll
            for (int k = 0; k < CW; ++k) { const unsigned w = yl[(tk + k) * 512 + tid]; a0 += w0[k] * bflo(w); a1 += w1[k] * bfhi(w); }
            o0[tk] = a0; o1[tk] = a1;
            const float ss = wave_sum(a0 * a0 + a1 * a1);
            if (lane == 0) part[tk * 8 + wave] = ss;
        }
        __syncthreads();
#pragma unroll
        for (int tk = 0; tk < TS; ++tk) {
            const f32x4 pa = *(const LAS f32x4*)(part + tk * 8), pb = *(const LAS f32x4*)(part + tk * 8 + 4);
            const float ri = __builtin_amdgcn_rsqf((((pa.x + pa.y) + (pa.z + pa.w)) + ((pb.x + pb.y) + (pb.z + pb.w))) * (1.0f / 1024.0f) + EPS);
            const float y0 = o0[tk] * ri * g0, y1 = o1[tk] * ri * g1;
            const float z0 = y0 * __builtin_amdgcn_rcpf(1.0f + __builtin_amdgcn_exp2f(y0 * -1.4426950408889634f)), z1 = y1 * __builtin_amdgcn_rcpf(1.0f + __builtin_amdgcn_exp2f(y1 * -1.4426950408889634f));
            *(unsigned*)(YC + (size_t)(tok0 + tk) * D + 2 * tid) = pk2(z0, z1);
        }
    }
    __syncthreads();
}

__global__ void __launch_bounds__(NWAVES * 64, 2) mk_fwd(Args args) {
    extern __shared__ __attribute__((aligned(16))) unsigned char lds[];
    Frame F;
    F.lds = (LAS unsigned char*)lds;
    F.MISC = (volatile LAS unsigned*)(F.lds + MISC_OFF);
    F.tid = threadIdx.x; F.lane = F.tid & 63; F.wave = __builtin_amdgcn_readfirstlane(F.tid >> 6);
    F.G = gridDim.x; { const int bx = blockIdx.x; F.vcu = (F.G % 8 == 0) ? (bx % 8) * (F.G / 8) + bx / 8 : bx; }
    unsigned char* ws = args.ws;
    F.ctl = (gu32*)(ws + WS_CTL);
    for (int u = F.tid; u < (LDS_BYTES - LDSCTL_OFF) / 4; u += NWAVES * 64) ((LAS unsigned*)(F.lds + LDSCTL_OFF))[u] = 0u;
    __syncthreads();
#if MK_ONE_LAUNCH
    XcdBarrier bar = xcd_barrier_post((unsigned*)(F.ctl + CW_BAR), F.MISC + 8);
#define GRID_BAR() xcd_barrier(bar)
#else
#define GRID_BAR() do {} while (0)
#endif
    const int lo = args.ph_lo, hi = args.ph_hi;
#ifndef PH_MASK
#define PH_MASK 0x7ff
#endif
#define IN(k) (((PH_MASK >> (k)) & 1) && lo <= (k) && (k) < hi)
#define SEAM(k) do { if (IN(k) && IN((k) + 1)) GRID_BAR(); __builtin_amdgcn_sched_barrier(0); asm volatile("" ::: "memory"); } while (0)
    using pg8::bf16_t;
    bf16_t* XB = (bf16_t*)(ws + WS_XB); float* SSQ = (float*)(ws + WS_SSQ);

    if (IN(0)) { p0_prologue(F, args); } SEAM(0);
    if (IN(1)) {
        pg8::Gemm g{XB, (const bf16_t*)(ws + WS_WIN), M, INWP, D}; pg8::StaticOrder S; S.init(M, INWP, F.G, (int)blockIdx.x);
        pg8::EpiIn E{SSQ, (const float*)(ws + WS_COS64), (const float*)(ws + WS_SIN64), (const float*)(ws + WS_COS32), (const float*)(ws + WS_SIN32), args.ev_g_q, args.ev_g_k, args.ev_g_kidx,
                     (bf16_t*)(ws + WS_Q), (bf16_t*)(ws + WS_KB), (bf16_t*)(ws + WS_VB), (float*)(ws + WS_QI), (float*)(ws + WS_KI), (float*)(ws + WS_WI), (bf16_t*)(ws + WS_U), (bf16_t*)(ws + WS_VBG), (float*)(ws + WS_SSQV), (bf16_t*)(ws + WS_QIB), (bf16_t*)(ws + WS_KIB)};
        pg8::gemm_phase<pg8::EpiIn, pg8::StaticOrder, true, true>(F.lds + RING_OFF, g, S, E);
    } SEAM(1);
    if (IN(2)) {
#ifndef NO_ATTN
        dsa_phase(F, args);
#endif
#ifndef NO_GATE
        gating_simple_phase(F, args);
#endif
    } SEAM(2);
    if (IN(3)) {
        pg8::Gemm g{(const bf16_t*)(ws + WS_MIX), (const bf16_t*)(ws + WS_WOUT), M, D, D}; pg8::StaticOrder S; S.init(M, D, F.G, (int)blockIdx.x);
        pg8::EpiRes E{args.x, args.out, XB, SSQ};
        pg8::gemm_phase<pg8::EpiRes, pg8::StaticOrder, true, true>(F.lds + RING_OFF, g, S, E);
    } SEAM(3);
    if (IN(4)) {
        pg8::Gemm g{XB, (const bf16_t*)(ws + WS_W1), M, FF, D}; pg8::StaticOrder S; S.init(M, FF, F.G, (int)blockIdx.x);
        pg8::EpiUp E{SSQ, (bf16_t*)(ws + WS_BIG), FF};
        pg8::gemm_phase<pg8::EpiUp, pg8::StaticOrder, true, true>(F.lds + RING_OFF, g, S, E);
    } SEAM(4);
    if (IN(5)) {
        pg8::Gemm g{(const bf16_t*)(ws + WS_BIG), (const bf16_t*)(ws + WS_W2), M, D, FF}; pg8::StaticOrder S; S.init(M, D, F.G, (int)blockIdx.x);
        pg8::EpiRes E{args.out, args.out, XB, SSQ};
        pg8::gemm_phase<pg8::EpiRes, pg8::StaticOrder, true, true>(F.lds + RING_OFF, g, S, E);
    } SEAM(5);
    if (IN(6)) {
        pg8::Gemm g{XB, (const bf16_t*)(ws + WS_WPW1), M, 2 * D, D}; pg8::StaticOrder S; S.init(M, 2 * D, F.G, (int)blockIdx.x);
        pg8::EpiGlu E{SSQ, (bf16_t*)(ws + WS_Y)};
        pg8::gemm_phase<pg8::EpiGlu, pg8::StaticOrder, true, true>(F.lds + RING_OFF, g, S, E);
    } SEAM(6);
    if (IN(7)) { conv_simple_phase(F, args); } SEAM(7);
    if (IN(8)) {
        pg8::Gemm g{(const bf16_t*)(ws + WS_YC), (const bf16_t*)(ws + WS_WPW2), M, D, D}; pg8::StaticOrder S; S.init(M, D, F.G, (int)blockIdx.x);
        pg8::EpiRes E{args.out, args.out, XB, SSQ};
        pg8::gemm_phase<pg8::EpiRes, pg8::StaticOrder, true, true>(F.lds + RING_OFF, g, S, E);
    } SEAM(8);
    if (IN(9)) {
        pg8::Gemm g{XB, (const bf16_t*)(ws + WS_W1) + (size_t)D * FF, M, FF, D}; pg8::StaticOrder S; S.init(M, FF, F.G, (int)blockIdx.x);
        pg8::EpiUp E{SSQ, (bf16_t*)(ws + WS_HID1), FF};
        pg8::gemm_phase<pg8::EpiUp, pg8::StaticOrder, true, true>(F.lds + RING_OFF, g, S, E);
    } SEAM(9);
    if (IN(10)) {
        pg8::Gemm g{(const bf16_t*)(ws + WS_HID1), (const bf16_t*)(ws + WS_W2) + (size_t)D * FF, M, D, FF}; pg8::StaticOrder S; S.init(M, D, F.G, (int)blockIdx.x);
        pg8::EpiRes E{args.out, args.out, nullptr, nullptr};
        pg8::gemm_phase<pg8::EpiRes, pg8::StaticOrder, true, true>(F.lds + RING_OFF, g, S, E);
    }
#undef IN
#undef SEAM
}

extern "C" void kernel_launch(void* const* d_in, const int* in_sizes, int n_in, void* d_out, int out_size, void* d_ws, size_t ws_size, hipStream_t stream) {
    static int grid = 0;
    if (grid == 0) {
        if (n_in != 20 || in_sizes[0] != M * D || out_size != M * D || ws_size < WS_END) { fprintf(stderr, "kernel_launch: unexpected problem shape (n_in %d, in0 %d, out %d, ws %zu < %zu); nothing launched\n", n_in, n_in > 0 ? in_sizes[0] : -1, out_size, ws_size, (size_t)WS_END); grid = -1; return; }
        int dev = 0, cus = 0, per_cu = 0;
        if (hipGetDevice(&dev) != hipSuccess || hipDeviceGetAttribute(&cus, hipDeviceAttributeMultiprocessorCount, dev) != hipSuccess) { grid = -1; return; }
        if (hipFuncSetAttribute((const void*)mk_fwd, hipFuncAttributeMaxDynamicSharedMemorySize, LDS_BYTES) != hipSuccess) { fprintf(stderr, "kernel_launch: hipFuncSetAttribute failed\n"); grid = -1; return; }
        if (hipOccupancyMaxActiveBlocksPerMultiprocessor(&per_cu, (const void*)mk_fwd, NWAVES * 64, LDS_BYTES) != hipSuccess || per_cu < 1) { fprintf(stderr, "kernel_launch: occupancy query says %d blocks per CU\n", per_cu); per_cu = 1; }
        (void)hipGetLastError();
        grid = cus;
    }
    if (grid < 0) return;
    (void)hipMemsetAsync((char*)d_ws + WS_CTL, 0, CTL_ZERO_BYTES, stream);
    Args a{};
    a.x = (const float*)d_in[0]; a.pos = (const int*)d_in[1]; a.ev_g_norm = (const float*)d_in[2]; a.ev_w_in = (const float*)d_in[3]; a.ev_g_q = (const float*)d_in[4]; a.ev_g_k = (const float*)d_in[5];
    a.ev_g_kidx = (const float*)d_in[6]; a.ev_g_vb = (const float*)d_in[7]; a.ev_w_s = (const float*)d_in[8]; a.ev_b_s = (const float*)d_in[9]; a.ev_w_out = (const float*)d_in[10];
    a.od_g_norm = (const float*)d_in[11]; a.od_w_pw1 = (const float*)d_in[12]; a.od_w_dw = (const float*)d_in[13]; a.od_b_dw = (const float*)d_in[14]; a.od_g_conv = (const float*)d_in[15]; a.od_w_pw2 = (const float*)d_in[16];
    a.ff_g_norm = (const float*)d_in[17]; a.ff_w1 = (const float*)d_in[18]; a.ff_w2 = (const float*)d_in[19];
    a.out = (float*)d_out; a.ws = (unsigned char*)d_ws;
    for (int i = 0; i < 32; ++i) a.invf64[i] = powf(10000.0f, -(float)i * 2.0f / 64.0f);
    for (int i = 0; i < 16; ++i) a.invf32[i] = powf(10000.0f, -(float)i * 2.0f / 32.0f);
#if MK_ONE_LAUNCH
    a.ph_lo = 0; a.ph_hi = N_PHASES;
    void* kargs[] = {&a};
    hipError_t e = hipLaunchCooperativeKernel((const void*)mk_fwd, dim3(grid), dim3(NWAVES * 64), kargs, LDS_BYTES, stream);
    if (e != hipSuccess) fprintf(stderr, "kernel_launch: cooperative launch failed: %s (grid %d)\n", hipGetErrorString(e), grid);
#else
    for (int p = 0; p < N_PHASES; ++p) {
        a.ph_lo = p; a.ph_hi = p + 1;
        hipLaunchKernelGGL(mk_fwd, dim3(grid), dim3(NWAVES * 64), LDS_BYTES, stream, a);
    }
#endif
}
```
